# Optimizing an MI355X kernel written in HIP

```python
import math
import jax, jax.numpy as jnp
from jax import lax
import numpy as np


D_MODEL = 1024
BATCH = 8
SEQ = 4096
DEPTH = 1
DEC_BATCH = 2
DEC_SEQ = 8192
PAST_LEN = 128

HEAD_DIM = 64
D_MIX = D_MODEL
D_A = D_MIX // 2
D_B = D_MIX - D_A
HA = D_A // HEAD_DIM
HKV_A = 2
G_A = HA // HKV_A
HB = D_B // (2 * HEAD_DIM)
WINDOW = 128
BLK = 128
N_BUCKETS = 32
HALF_BUCKETS = N_BUCKETS // 2
MAX_EXACT = HALF_BUCKETS // 2
MAX_DIST = 128
ALPHA = (2.0 * DEPTH) ** 0.25
BETA = (8.0 * DEPTH) ** -0.25
LN_EPS = 1e-5
SUBLN_EPS = 1e-5
NEG_INF = -1e30
SPLIT_SIZES = (D_A, HKV_A * HEAD_DIM, HKV_A * HEAD_DIM, D_A, D_B, D_B, D_B, D_B)
SPLIT_OFFSETS = tuple(int(v) for v in np.cumsum(SPLIT_SIZES)[:-1])
D_IN = int(sum(SPLIT_SIZES))

kernel_name = 'hybrid_swa_diffattn_deepnorm_encoder'


def t5_bucket(rel):
    sign = jnp.where(rel > 0, HALF_BUCKETS, 0)
    n = jnp.abs(rel)
    nf = jnp.maximum(n, 1).astype(jnp.float32)
    large = MAX_EXACT + (jnp.log(nf / MAX_EXACT) / math.log(MAX_DIST / MAX_EXACT)
                         * (HALF_BUCKETS - MAX_EXACT)).astype(jnp.int32)
    large = jnp.minimum(large, HALF_BUCKETS - 1)
    return (sign + jnp.where(n < MAX_EXACT, n, large)).astype(jnp.int32)


def layer_norm(x, g, b):
    xf = x.astype(jnp.float32)
    mu = jnp.mean(xf, -1, keepdims=True)
    var = jnp.mean(jnp.square(xf - mu), -1, keepdims=True)
    y = (xf - mu) * lax.rsqrt(var + LN_EPS) * g.astype(jnp.float32) + b.astype(jnp.float32)
    return y.astype(x.dtype)


def rms_norm(x, w):
    xf = x.astype(jnp.float32)
    y = xf * lax.rsqrt(jnp.mean(jnp.square(xf), -1, keepdims=True) + SUBLN_EPS) * w.astype(jnp.float32)
    return y.astype(x.dtype)


def window_gqa(q, k, v, sink, rel_bias):
    B, S, _ = q.shape
    NB = S // BLK
    qb = q.reshape(B, NB, BLK, HKV_A, G_A, HEAD_DIM)
    pad = ((0, 0), (WINDOW, WINDOW), (0, 0), (0, 0))
    kp = jnp.pad(k.reshape(B, S, HKV_A, HEAD_DIM), pad).reshape(B, NB + 2, BLK, HKV_A, HEAD_DIM)
    vp = jnp.pad(v.reshape(B, S, HKV_A, HEAD_DIM), pad).reshape(B, NB + 2, BLK, HKV_A, HEAD_DIM)
    kw = jnp.concatenate([kp[:, :-2], kp[:, 1:-1], kp[:, 2:]], axis=2)
    vw = jnp.concatenate([vp[:, :-2], vp[:, 1:-1], vp[:, 2:]], axis=2)
    a = jnp.arange(BLK, dtype=jnp.int32)[:, None]
    kk = jnp.arange(3 * BLK, dtype=jnp.int32)[None, :]
    rel = kk - BLK - a
    bias = rel_bias[:, :HA][t5_bucket(rel)].astype(jnp.float32)
    bias = bias.transpose(2, 0, 1).reshape(HKV_A, G_A, BLK, 3 * BLK)
    kpos = jnp.arange(NB, dtype=jnp.int32)[:, None, None] * BLK + kk[None] - BLK
    valid = (jnp.abs(rel) <= WINDOW)[None] & (kpos >= 0) & (kpos < S)
    logits = jnp.einsum('bnqhgd,bnkhd->bnhgqk', qb, kw).astype(jnp.float32) * (HEAD_DIM ** -0.5)
    logits = jnp.where(valid[None, :, None, None], logits + bias[None, None], NEG_INF)
    s = sink.reshape(HKV_A, G_A)[None, None, :, :, None, None].astype(jnp.float32)
    m = jnp.maximum(jnp.max(logits, -1, keepdims=True), s)
    e = jnp.exp(logits - m)
    p = e / (jnp.sum(e, -1, keepdims=True) + jnp.exp(s - m))
    o = jnp.einsum('bnhgqk,bnkhd->bnqhgd', p.astype(v.dtype), vw)
    return o.reshape(B, S, HA * HEAD_DIM)


def diff_attention(q, k, v, lq1, lk1, lq2, lk2, subln_w, rel_bias, lambda_init):
    B, S, _ = q.shape
    NB = S // BLK
    E = 2 * HEAD_DIM
    qh = q.reshape(B, NB, BLK, HB, 2, HEAD_DIM).transpose(1, 0, 2, 3, 4, 5)
    kh = k.reshape(B, S, HB, 2, HEAD_DIM)
    vh = v.reshape(B, S, HB, E)
    lam = (jnp.exp(jnp.sum(lq1.astype(jnp.float32) * lk1.astype(jnp.float32)))
           - jnp.exp(jnp.sum(lq2.astype(jnp.float32) * lk2.astype(jnp.float32))) + lambda_init)
    table = rel_bias[:, HA:].astype(jnp.float32)
    kpos = jnp.arange(S, dtype=jnp.int32)

    def block(args):
        qb, i = args
        qpos = i * BLK + jnp.arange(BLK, dtype=jnp.int32)
        bias = table[t5_bucket(kpos[None, :] - qpos[:, None])].transpose(2, 0, 1)
        logits = jnp.einsum('bqhmd,bkhmd->bhmqk', qb, kh).astype(jnp.float32) * (HEAD_DIM ** -0.5)
        p = jax.nn.softmax(logits + bias[None, :, None], axis=-1)
        w = p[:, :, 0] - lam * p[:, :, 1]
        return jnp.einsum('bhqk,bkhe->bqhe', w.astype(vh.dtype), vh)

    o = lax.map(block, (qh, jnp.arange(NB, dtype=jnp.int32)))
    o = o.transpose(1, 0, 2, 3, 4).reshape(B, S, HB, E)
    o = rms_norm(o, subln_w) * (1.0 - lambda_init)
    return o.reshape(B, S, HB * E)


def hybrid_layer(x, c, w_in, w_out, w_ada, b_ada, ln_g, ln_b, sink,
                 lq1, lk1, lq2, lk2, subln_w, rel_bias, lambda_init):
    mod = jax.nn.silu(c) @ w_ada + b_ada
    shift, scale, gate = jnp.split(mod, 3, axis=-1)
    u = x * (1.0 + scale[:, None]) + shift[:, None]
    proj = u @ w_in
    qa, ka, va, ga, qb, kb, vb, gb = jnp.split(proj, SPLIT_OFFSETS, axis=-1)
    oa = window_gqa(qa, ka, va, sink, rel_bias) * jax.nn.silu(ga)
    ob = diff_attention(qb, kb, vb, lq1, lk1, lq2, lk2, subln_w, rel_bias, lambda_init) * jax.nn.silu(gb)
    h = jnp.concatenate([oa, ob], axis=-1) @ w_out
    return layer_norm(ALPHA * x + gate[:, None] * h, ln_g, ln_b)


def setup_inputs(seed: int = 0) -> dict:
    key = jax.random.key(seed)
    ks = jax.random.split(key, 20)
    f32 = jnp.float32
    col_scale = np.ones((D_IN,), np.float32)
    off = np.concatenate([[0], np.cumsum(SPLIT_SIZES)])
    for idx in (2, 6):
        col_scale[off[idx]:off[idx + 1]] = BETA
    w_in = jax.random.normal(ks[4], (DEPTH, D_MODEL, D_IN), f32) * (D_MODEL ** -0.5) * jnp.asarray(col_scale)
    return {
        'x_prompt': jax.random.normal(ks[0], (BATCH, SEQ, D_MODEL), f32),
        'x_sample': jax.random.normal(ks[1], (DEC_BATCH, DEC_SEQ, D_MODEL), f32),
        'c_prompt': jax.random.normal(ks[2], (BATCH, D_MODEL), f32),
        'c_sample': jax.random.normal(ks[3], (DEC_BATCH, D_MODEL), f32),
        'w_in': w_in,
        'w_out': jax.random.normal(ks[5], (DEPTH, D_MIX, D_MODEL), f32) * (D_MIX ** -0.5) * BETA,
        'w_ada': jax.random.normal(ks[6], (DEPTH, D_MODEL, 3 * D_MODEL), f32) * (D_MODEL ** -0.5),
        'b_ada': jax.random.normal(ks[7], (DEPTH, 3 * D_MODEL), f32) * 0.02,
        'ln_g': 1.0 + 0.02 * jax.random.normal(ks[8], (DEPTH, D_MODEL), f32),
        'ln_b': 0.02 * jax.random.normal(ks[9], (DEPTH, D_MODEL), f32),
        'attn_sink': jax.random.normal(ks[10], (DEPTH, HA), f32),
        'lambda_q1': 0.1 * jax.random.normal(ks[11], (DEPTH, HEAD_DIM), f32),
        'lambda_k1': 0.1 * jax.random.normal(ks[12], (DEPTH, HEAD_DIM), f32),
        'lambda_q2': 0.1 * jax.random.normal(ks[13], (DEPTH, HEAD_DIM), f32),
        'lambda_k2': 0.1 * jax.random.normal(ks[14], (DEPTH, HEAD_DIM), f32),
        'subln_w': 1.0 + 0.02 * jax.random.normal(ks[15], (DEPTH, 2 * HEAD_DIM), f32),
        'rel_bias': 0.5 * jax.random.normal(ks[16], (N_BUCKETS, HA + HB), f32),
    }


def reference(x_prompt, x_sample, c_prompt, c_sample, w_in, w_out, w_ada, b_ada,
              ln_g, ln_b, attn_sink, lambda_q1, lambda_k1, lambda_q2, lambda_k2,
              subln_w, rel_bias):
    xp = x_prompt
    xs = x_sample
    for l in range(DEPTH):
        lambda_init = 0.8 - 0.6 * math.exp(-0.3 * l)
        xp = hybrid_layer(xp, c_prompt, w_in[l], w_out[l], w_ada[l], b_ada[l], ln_g[l], ln_b[l],
                          attn_sink[l], lambda_q1[l], lambda_k1[l], lambda_q2[l], lambda_k2[l],
                          subln_w[l], rel_bias, lambda_init)
        xs = hybrid_layer(xs, c_sample, w_in[l], w_out[l], w_ada[l], b_ada[l], ln_g[l], ln_b[l],
                          attn_sink[l], lambda_q1[l], lambda_k1[l], lambda_q2[l], lambda_k2[l],
                          subln_w[l], rel_bias, lambda_init)
    y_prompt = xp
    y_sample = xs
    return (y_prompt, y_sample)
```

```cpp
#include <hip/hip_runtime.h>
#include <cstdio>
#include <cstdint>

#ifndef MK_N_LAUNCHES
#define MK_N_LAUNCHES 1
#endif
constexpr int N_LAUNCHES = MK_N_LAUNCHES;
constexpr int PER_PHASE = 6;

constexpr int DM = 1024, NTOK = 49152, NPROMPT = 32768, DIN = 3328, SEQ_P = 4096, SEQ_S = 8192;
constexpr float ALPHA = 1.189207115002721f;
constexpr float LN_EPS = 1e-5f, SUBLN_EPS = 1e-5f, LAMBDA_INIT = 0.2f;
__device__ __forceinline__ int tok_batch(int m) { return m < NPROMPT ? (m >> 12) : 8 + ((m - NPROMPT) >> 13); }
__device__ __forceinline__ int t5_bucket(int rel) {
    const int n = rel < 0 ? -rel : rel;
    const int b = n < 8 ? n : n < 12 ? 8 : n < 16 ? 9 : n < 23 ? 10 : n < 32 ? 11 : n < 46 ? 12 : n < 64 ? 13 : n < 91 ? 14 : 15;
    return b + (rel > 0 ? 16 : 0);
}
__device__ __forceinline__ float silu_f(float x) { return x * __builtin_amdgcn_rcpf(1.f + __builtin_amdgcn_exp2f(-1.4426950408889634f * x)); }

namespace pg8 {
#define PG8_LAS __attribute__((address_space(3)))
typedef unsigned short bf16_t;
typedef short bf16x8 __attribute__((ext_vector_type(8)));
typedef float f32x4 __attribute__((ext_vector_type(4)));
typedef unsigned u32x4 __attribute__((ext_vector_type(4)));
constexpr int BM = 256, BK = 64, HALF = 128, HTB = HALF * BK * 2  , STAGE_BYTES = 8 * HTB, NXCD = 8, WGM = 8;

__host__ __device__ __forceinline__ int lds_byte(int r, int c) { const int st = (r >> 4) * 2 + (c >> 5), rr = r & 15, cc = c & 31, ob = rr * 64 + cc * 2; return st * 1024 + (ob ^ (((ob >> 9) & 1) << 5)); }
__host__ __device__ __forceinline__ void stage_rc(int b, int& R, int& C) { const int st = b / 1024, sb = b % 1024, swz = sb ^ (((sb >> 9) & 1) << 5); R = (st >> 1) * 16 + swz / 64; C = (st & 1) * 32 + (swz % 64) / 2; }
__host__ __device__ __forceinline__ int perm32(int rho) { const int n = rho >> 4, i = rho & 15; return 8 * (i >> 2) + 4 * n + (i & 3); }

struct Unit { int pm, pn; };
struct Gemm { const bf16_t* A; const bf16_t* Bt; int M, N, K; };

struct StaticOrder {
    int nM, nN, nwg, G, c;
    __host__ __device__ void init(int M, int N, int G_, int c_) { nM = M / BM; nN = N / BM; nwg = nM * nN; G = G_; c = c_; }
    __host__ __device__ bool next(int i, Unit& u) const {
        const long L = (long)i * G + c; if (L >= nwg) return false;
        int wgid = (int)L; { const int q = nwg / NXCD, r = nwg % NXCD, xcd = wgid % NXCD, off = wgid / NXCD; wgid = (xcd < r ? xcd * (q + 1) : r * (q + 1) + (xcd - r) * q) + off; }
        const int nig = WGM * nN, gid = wgid / nig, fm = gid * WGM, gsz = (nM - fm) < WGM ? (nM - fm) : WGM;
        u.pm = fm + ((wgid % nig) % gsz); u.pn = (wgid % nig) / gsz; return true;
    }
    __device__ __forceinline__ void a_ready(const Unit&) const {}
    __device__ __forceinline__ void done(const Unit&) const {}
};

__device__ __forceinline__ unsigned cvt_pk_bf16(float lo, float hi) { unsigned r; asm volatile("v_cvt_pk_bf16_f32 %0, %1, %2" : "=v"(r) : "v"(lo), "v"(hi)); return r; }
struct EpiProj {
    static constexpr bool PERM = true, AFTER_DRAIN = false;
    bf16_t* O; int ldc;
    __device__ __forceinline__ void operator()(const f32x4 (&acc)[2][2][4][2], const Unit& u, int wr, int wc, int fr, int fq) const {
        const int row0 = u.pm * BM + wr * 64 + fr, col0 = u.pn * BM + wc * 32 + 8 * fq;
        const bool act = (u.pn == 3 || u.pn == 4 || u.pn == 11 || u.pn == 12);
#pragma unroll
        for (int ai = 0; ai < 2; ++ai)
#pragma unroll
            for (int m = 0; m < 4; ++m) { bf16_t* rowp = O + (size_t)(row0 + ai * HALF + m * 16) * ldc + col0;
#pragma unroll
                for (int bj = 0; bj < 2; ++bj) { f32x4 v0 = acc[ai][bj][m][0], v1 = acc[ai][bj][m][1];
                    if (act) { v0 = (f32x4){silu_f(v0[0]), silu_f(v0[1]), silu_f(v0[2]), silu_f(v0[3])}; v1 = (f32x4){silu_f(v1[0]), silu_f(v1[1]), silu_f(v1[2]), silu_f(v1[3])}; }
                    u32x4 w; w.x = cvt_pk_bf16(v0[0], v0[1]); w.y = cvt_pk_bf16(v0[2], v0[3]); w.z = cvt_pk_bf16(v1[0], v1[1]); w.w = cvt_pk_bf16(v1[2], v1[3]);
                    *(u32x4*)(rowp + bj * HALF) = w; } }
    }
};
struct EpiResid {
    static constexpr bool PERM = false, AFTER_DRAIN = false;
    const float* xp; const float* xs; const float* mod; float* out;
    __device__ __forceinline__ void operator()(const f32x4 (&acc)[2][2][4][2], const Unit& u, int wr, int wc, int fr, int fq) const {
        const int rowt = u.pm * BM; const int b = tok_batch(rowt);
        const float* gate = mod + b * 3072 + 2048;
        const float* xb = rowt < NPROMPT ? xp + (size_t)rowt * DM : xs + (size_t)(rowt - NPROMPT) * DM;
        const int col0 = u.pn * BM + wc * 32 + 4 * fq;
        f32x4 gv[2][2];
#pragma unroll
        for (int bj = 0; bj < 2; ++bj)
#pragma unroll
            for (int n = 0; n < 2; ++n) gv[bj][n] = *(const f32x4*)(gate + col0 + bj * HALF + n * 16);
#pragma unroll
        for (int ai = 0; ai < 2; ++ai)
#pragma unroll
            for (int m = 0; m < 4; ++m) { const int r = ai * HALF + wr * 64 + m * 16 + fr; const size_t off = (size_t)r * DM + col0;
#pragma unroll
                for (int bj = 0; bj < 2; ++bj)
#pragma unroll
                    for (int n = 0; n < 2; ++n) { const f32x4 xv = *(const f32x4*)(xb + off + bj * HALF + n * 16);
                        *(f32x4*)(out + (size_t)rowt * DM + off + bj * HALF + n * 16) = xv * ALPHA + gv[bj][n] * acc[ai][bj][m][n]; }
                if (m & 1) asm volatile("" ::: "memory"); }
    }
};

template <class Epi, class Sched, bool ALIGN_EPI = false, bool SP2 = false>
__device__ __forceinline__ void gemm_phase(PG8_LAS unsigned char* lds, const Gemm g, const Sched& S, const Epi& E) {
    const int tid = threadIdx.x, wid = __builtin_amdgcn_readfirstlane(tid >> 6), lane = tid & 63, wr = wid >> 2, wc = wid & 3, fr = lane & 15, fq = lane >> 4;
    const int K = g.K, nt = K / BK;
    unsigned voffA[2], voffB[2];
#pragma unroll
    for (int i = 0; i < 2; ++i) { int R, C; stage_rc(tid * 16 + i * 8192, R, C); const int Rb = Epi::PERM ? ((R & ~31) + perm32(R & 31)) : R;
        voffA[i] = (unsigned)(R * K + C) * 2u; voffB[i] = (unsigned)(Rb * K + C) * 2u; }
    const size_t kstep = (size_t)(BK * 2);
    const size_t hstep = (size_t)HALF * K * 2;
    const size_t tstep = 2 * hstep;
    const unsigned ldsw = (unsigned)wid * 1024u;
    const int aoff = lds_byte(wr * 64 + fr, fq * 8), boff = lds_byte(wc * 32 + fr, fq * 8);
#define PG8_SA(b, h) (((b) * 2 + (h)) * HTB)
#define PG8_SB(b, h) ((4 + (b) * 2 + (h)) * HTB)
#define PG8_STAGE(bufoff, gbase, voff) do { _Pragma("unroll") for (int _i = 0; _i < 2; ++_i) \
        __builtin_amdgcn_global_load_lds((const unsigned*)((const char*)(gbase) + (voff)[_i]), (PG8_LAS unsigned*)(lds + (bufoff) + ldsw + _i * 8192), 16, 0, 0); } while (0)
#define PG8_LDA(dst, b, h) do { _Pragma("unroll") for (int m = 0; m < 4; ++m) _Pragma("unroll") for (int k = 0; k < 2; ++k) dst[m][k] = *(const PG8_LAS bf16x8*)(lds + PG8_SA(b, h) + aoff + m * 2048 + k * 1024); } while (0)
#define PG8_LDB(dst, b, h) do { _Pragma("unroll") for (int n = 0; n < 2; ++n) _Pragma("unroll") for (int k = 0; k < 2; ++k) dst[n][k] = *(const PG8_LAS bf16x8*)(lds + PG8_SB(b, h) + boff + n * 2048 + k * 1024); } while (0)
#define PG8_MMA(ai, bj, At, Bt) do { __builtin_amdgcn_s_setprio(1); _Pragma("unroll") for (int m = 0; m < 4; ++m) _Pragma("unroll") for (int n = 0; n < 2; ++n) _Pragma("unroll") for (int k = 0; k < 2; ++k) \
        acc[ai][bj][m][n] = __builtin_amdgcn_mfma_f32_16x16x32_bf16(Bt[n][k], At[m][k], acc[ai][bj][m][n], 0, 0, 0); __builtin_amdgcn_s_setprio(0); } while (0)
#define PG8_WAIT_V(n) asm volatile("s_waitcnt vmcnt(" #n ")" ::: "memory")
#define PG8_WAIT_L(n) asm volatile("s_waitcnt lgkmcnt(" #n ")" ::: "memory")
#define PG8_BAR __builtin_amdgcn_s_barrier()
#define PG8_SCHED __builtin_amdgcn_sched_barrier(0)
    Unit cur, nxt; int ui = 0;
    if (!S.next(0, cur)) return;
    f32x4 acc[2][2][4][2];
#pragma unroll
    for (int a = 0; a < 2; ++a)
#pragma unroll
        for (int b = 0; b < 2; ++b)
#pragma unroll
            for (int m = 0; m < 4; ++m)
#pragma unroll
                for (int n = 0; n < 2; ++n) acc[a][b][m][n] = (f32x4){0.f, 0.f, 0.f, 0.f};
    bf16x8 At[4][2], B0[2][2], B1[2][2];
    const char* cA = (const char*)g.A + (size_t)cur.pm * tstep; const char* cB = (const char*)g.Bt + (size_t)cur.pn * tstep;
    S.a_ready(cur);
    if constexpr (SP2) {
        PG8_STAGE(PG8_SB(0, 0), cB, voffB); PG8_STAGE(PG8_SB(0, 1), cB + hstep, voffB); PG8_STAGE(PG8_SA(0, 0), cA, voffA); PG8_STAGE(PG8_SA(0, 1), cA + hstep, voffA);
        if (wr == 1) PG8_BAR;
        PG8_WAIT_V(2); PG8_BAR;
        PG8_STAGE(PG8_SB(1, 0), cB + kstep, voffB); PG8_STAGE(PG8_SA(1, 0), cA + kstep, voffA); PG8_STAGE(PG8_SB(1, 1), cB + hstep + kstep, voffB);
        PG8_WAIT_V(6); PG8_BAR;
    } else {
        PG8_STAGE(PG8_SB(0, 0), cB, voffB); PG8_STAGE(PG8_SA(0, 0), cA, voffA); PG8_STAGE(PG8_SB(0, 1), cB + hstep, voffB); PG8_STAGE(PG8_SA(0, 1), cA + hstep, voffA);
        if (wr == 1) PG8_BAR;
        PG8_WAIT_V(4); PG8_BAR;
        PG8_STAGE(PG8_SB(1, 0), cB + kstep, voffB); PG8_STAGE(PG8_SA(1, 0), cA + kstep, voffA); PG8_STAGE(PG8_SB(1, 1), cB + hstep + kstep, voffB);
        PG8_WAIT_V(6); PG8_BAR;
    }
    for (;;) {
        const bool has_next = S.next(ui + 1, nxt);
        const char* nA = has_next ? (const char*)g.A + (size_t)nxt.pm * tstep : cA; const char* nB = has_next ? (const char*)g.Bt + (size_t)nxt.pn * tstep : cB;
        for (int t = 0; t < nt; t += 2) {
            const bool last = (t == nt - 2);
            const char* a1 = cA + (size_t)(t + 1) * kstep;
            const char* a2 = last ? nA : cA + (size_t)(t + 2) * kstep; const char* b2 = last ? nB : cB + (size_t)(t + 2) * kstep;
            const char* a3 = a2 + kstep; const char* b3 = b2 + kstep;
            if (last && has_next) S.a_ready(nxt);
            if constexpr (SP2) {
            PG8_LDB(B0, 0, 0); PG8_LDB(B1, 0, 1); PG8_SCHED; PG8_LDA(At, 0, 0); PG8_STAGE(PG8_SA(1, 1), a1 + hstep, voffA);
            PG8_WAIT_V(8); PG8_WAIT_L(0); PG8_BAR; PG8_MMA(0, 0, At, B0); PG8_MMA(0, 1, At, B1); PG8_BAR; PG8_SCHED;
            PG8_LDA(At, 0, 1); PG8_STAGE(PG8_SB(0, 0), b2, voffB); PG8_STAGE(PG8_SB(0, 1), b2 + hstep, voffB); PG8_STAGE(PG8_SA(0, 0), a2, voffA);
            PG8_WAIT_V(8); PG8_WAIT_L(0); PG8_BAR; PG8_MMA(1, 0, At, B0); PG8_MMA(1, 1, At, B1); PG8_BAR; PG8_SCHED;
            PG8_LDB(B0, 1, 0); PG8_LDB(B1, 1, 1); PG8_SCHED; PG8_LDA(At, 1, 0); PG8_STAGE(PG8_SA(0, 1), a2 + hstep, voffA);
            PG8_WAIT_V(8); PG8_WAIT_L(0); PG8_BAR; PG8_MMA(0, 0, At, B0); PG8_MMA(0, 1, At, B1); PG8_BAR; PG8_SCHED;
            PG8_LDA(At, 1, 1); PG8_STAGE(PG8_SB(1, 0), b3, voffB); PG8_STAGE(PG8_SB(1, 1), b3 + hstep, voffB); PG8_STAGE(PG8_SA(1, 0), a3, voffA);
            PG8_WAIT_V(8); PG8_WAIT_L(0); PG8_BAR; PG8_MMA(1, 0, At, B0); PG8_MMA(1, 1, At, B1); PG8_BAR; PG8_SCHED;
            } else {
            PG8_LDB(B0, 0, 0); PG8_SCHED; PG8_LDA(At, 0, 0); PG8_STAGE(PG8_SA(1, 1), a1 + hstep, voffA);
            PG8_WAIT_L(8); PG8_BAR; PG8_WAIT_L(0); PG8_MMA(0, 0, At, B0); PG8_BAR; PG8_SCHED;
            PG8_LDB(B1, 0, 1); PG8_STAGE(PG8_SB(0, 0), b2, voffB);
            PG8_BAR; PG8_WAIT_L(0); PG8_MMA(0, 1, At, B1); PG8_BAR;
            PG8_LDA(At, 0, 1); PG8_STAGE(PG8_SA(0, 0), a2, voffA);
            PG8_BAR; PG8_WAIT_L(0); PG8_MMA(1, 0, At, B0); PG8_BAR; PG8_SCHED;
            PG8_STAGE(PG8_SB(0, 1), b2 + hstep, voffB);
            PG8_WAIT_V(6); PG8_BAR; PG8_MMA(1, 1, At, B1); PG8_BAR;
            PG8_LDB(B0, 1, 0); PG8_SCHED; PG8_LDA(At, 1, 0); PG8_STAGE(PG8_SA(0, 1), a2 + hstep, voffA);
            PG8_WAIT_L(8); PG8_BAR; PG8_WAIT_L(0); PG8_MMA(0, 0, At, B0); PG8_BAR; PG8_SCHED;
            PG8_LDB(B1, 1, 1); PG8_STAGE(PG8_SB(1, 0), b3, voffB);
            PG8_BAR; PG8_WAIT_L(0); PG8_MMA(0, 1, At, B1); PG8_BAR;
            PG8_LDA(At, 1, 1); PG8_STAGE(PG8_SA(1, 0), a3, voffA);
            PG8_BAR; PG8_WAIT_L(0); PG8_MMA(1, 0, At, B0); PG8_BAR; PG8_SCHED;
            PG8_STAGE(PG8_SB(1, 1), b3 + hstep, voffB);
            PG8_WAIT_V(6); PG8_BAR; PG8_MMA(1, 1, At, B1); PG8_BAR;
            }
        }
        if constexpr (ALIGN_EPI) { if (wr == 0) PG8_BAR; }
        if constexpr (!Epi::AFTER_DRAIN) { E(acc, cur, wr, wc, fr, fq); S.done(cur); }
        if (!has_next) break;
#pragma unroll
        for (int a = 0; a < 2; ++a)
#pragma unroll
            for (int b = 0; b < 2; ++b)
#pragma unroll
                for (int m = 0; m < 4; ++m)
#pragma unroll
                    for (int n = 0; n < 2; ++n) acc[a][b][m][n] = (f32x4){0.f, 0.f, 0.f, 0.f};
        cur = nxt; cA = nA; cB = nB; ++ui;
        if constexpr (ALIGN_EPI) { if (wr == 1) PG8_BAR; }
    }
    PG8_WAIT_V(0);
    if constexpr (!ALIGN_EPI) { if (wr == 0) PG8_BAR; }
    PG8_BAR;
    if constexpr (Epi::AFTER_DRAIN) { E.fused(acc, cur, wr, wc, fr, fq, lds, wid, lane); S.done(cur); }
#undef PG8_SA
#undef PG8_SB
#undef PG8_STAGE
#undef PG8_LDA
#undef PG8_LDB
#undef PG8_MMA
#undef PG8_WAIT_V
#undef PG8_WAIT_L
#undef PG8_BAR
#undef PG8_SCHED
}
}
#ifndef PG8_SP2
#define PG8_SP2 true
#endif
#ifndef PG8_ALIGN
#define PG8_ALIGN true
#endif
namespace att {
typedef unsigned short bf16;
using bf16x8 = __attribute__((ext_vector_type(8))) short;
using s16x4  = __attribute__((ext_vector_type(4))) short;
using f32x16 = __attribute__((ext_vector_type(16))) float;
using u32x4  = __attribute__((ext_vector_type(4))) unsigned;
constexpr int KVBLK = 64, LDP = DIN;
constexpr float SCALE = 0.125f, C = SCALE * 1.4426950408889634f, THRR = 8.f / SCALE;
constexpr int L_V = 0, L_K = 32768, L_WS = 65536, L_TAB = 67584, L_END = 75776;
#define SBAR() __builtin_amdgcn_sched_barrier(0)
__device__ __forceinline__ int crow(int r, int hi) { return (r & 3) + 8 * (r >> 2) + 4 * hi; }
__device__ __forceinline__ unsigned cvtpk(float lo, float hi) { unsigned r; asm volatile("v_cvt_pk_bf16_f32 %0, %1, %2" : "=v"(r) : "v"(lo), "v"(hi)); return r; }
__device__ __forceinline__ float bf2f(bf16 v) { return __uint_as_float((unsigned)v << 16); }
__device__ __forceinline__ bf16 f2bf(float f) { unsigned u = __float_as_uint(f); return (bf16)((u + 0x7fffu + ((u >> 16) & 1u)) >> 16); }
template <int KW> __device__ __forceinline__ int kswz(int row, int colB) { return row * (KW * 2) + (colB ^ ((row & 7) << 4)); }
template <int NCB> __device__ __forceinline__ int v_st(int k, int c) { const int kk = (k & ~0xC) | ((k & 4) << 1) | ((k & 8) >> 1); return ((kk >> 3) * NCB + (c >> 5)) * 512 + ((kk & 7) * 32 + (c & 31)) * 2; }
__device__ __forceinline__ int v_rd_base(int lane) { return ((lane & 3) << 3) | (((lane >> 2) & 3) << 6) | (((lane >> 4) & 1) << 5) | (((lane >> 5) & 1) << 8); }
template <int NCB> constexpr int v_rd_off(int d0, int ks, int half) { return ((2 * ks + half) * NCB + d0) * 512; }
template <int OFF> __device__ __forceinline__ s16x4 tr_read(int vb) { s16x4 r; asm volatile("ds_read_b64_tr_b16 %0, %1 offset:%2" : "=&v"(r) : "v"(vb), "i"(OFF) : "memory"); return r; }

__device__ __forceinline__ void partialSM(f32x16& p0, f32x16& p1, float& m_reg, float& mn, float& alpha, float cb) {
  float pmax = p0[0];
#pragma unroll
  for (int r = 1; r < 16; ++r) pmax = fmaxf(pmax, p0[r]);
#pragma unroll
  for (int r = 0; r < 16; ++r) pmax = fmaxf(pmax, p1[r]);
  { auto rr = __builtin_amdgcn_permlane32_swap(__float_as_uint(pmax), __float_as_uint(pmax), false, false);
    pmax = fmaxf(__uint_as_float(rr[0]), __uint_as_float(rr[1])); }
  pmax += cb;
  if (__builtin_expect(__all(pmax - m_reg <= THRR), 1)) { mn = m_reg; alpha = 1.f; }
  else { mn = fmaxf(m_reg, pmax); alpha = __builtin_amdgcn_exp2f((m_reg - mn) * C); m_reg = mn; }
  const float mnC = (cb - mn) * C;
#pragma unroll
  for (int r = 0; r < 16; ++r) p0[r] = fmaf(p0[r], C, mnC);
#pragma unroll
  for (int r = 0; r < 16; ++r) p1[r] = fmaf(p1[r], C, mnC);
#pragma unroll
  for (int r = 0; r < 16; ++r) p0[r] = __builtin_amdgcn_exp2f(p0[r]);
}
__device__ __forceinline__ void finishSM(f32x16& p0, f32x16& p1, float alpha, float& l_reg, bf16x8& pa0, bf16x8& pa1, bf16x8& pa2, bf16x8& pa3) {
#pragma unroll
  for (int r = 0; r < 16; ++r) p1[r] = __builtin_amdgcn_exp2f(p1[r]);
  float ps = 0;
#pragma unroll
  for (int r = 0; r < 16; ++r) ps += p0[r];
#pragma unroll
  for (int r = 0; r < 16; ++r) ps += p1[r];
  { auto rr = __builtin_amdgcn_permlane32_swap(__float_as_uint(ps), __float_as_uint(ps), false, false);
    ps = __uint_as_float(rr[0]) + __uint_as_float(rr[1]); }
  l_reg = l_reg * alpha + ps;
#define PK4(P, BASE, OUT) do { unsigned a0 = cvtpk(P[BASE + 0], P[BASE + 1]), a1 = cvtpk(P[BASE + 2], P[BASE + 3]);   \
    unsigned b0 = cvtpk(P[BASE + 4], P[BASE + 5]), b1 = cvtpk(P[BASE + 6], P[BASE + 7]);                              \
    auto r0 = __builtin_amdgcn_permlane32_swap(a0, b0, false, false); auto r1 = __builtin_amdgcn_permlane32_swap(a1, b1, false, false); \
    u32x4 w = {r0[0], r1[0], r0[1], r1[1]}; OUT = *reinterpret_cast<bf16x8*>(&w); } while (0)
  PK4(p0, 0, pa0); PK4(p0, 8, pa1); PK4(p1, 0, pa2); PK4(p1, 8, pa3);
#undef PK4
}
template <int KW> __device__ __forceinline__ void qkt(f32x16& p0, f32x16& p1, const char* Ks, const bf16x8* qr, int r32, int hi, int kq) {
  p0 = f32x16{}; p1 = f32x16{};
#pragma unroll
  for (int d0 = 0; d0 < 4; ++d0) { const int cb = (kq + d0 * 16 + hi * 8) * 2;
    const bf16x8 b0 = *reinterpret_cast<const bf16x8*>(Ks + kswz<KW>(r32, cb));
    const bf16x8 b1 = *reinterpret_cast<const bf16x8*>(Ks + kswz<KW>(32 + r32, cb));
    p0 = __builtin_amdgcn_mfma_f32_32x32x16_bf16(b0, qr[d0], p0, 0, 0, 0);
    p1 = __builtin_amdgcn_mfma_f32_32x32x16_bf16(b1, qr[d0], p1, 0, 0, 0); }
}
__device__ __forceinline__ void add_bias(f32x16& p0, f32x16& p1, const float* tab, int base) {
#pragma unroll
  for (int r = 0; r < 16; ++r) { const int o = (r & 3) + 8 * (r >> 2); p0[r] += tab[base + o]; p1[r] += tab[base + o + 32]; }
}
template <int D0, int NCB> __device__ __forceinline__ void pv_one(f32x16& od, int vb, bf16x8 pa0, bf16x8 pa1, bf16x8 pa2, bf16x8 pa3) {
  const s16x4 l0 = tr_read<v_rd_off<NCB>(D0, 0, 0)>(vb), h0 = tr_read<v_rd_off<NCB>(D0, 0, 1)>(vb), l1 = tr_read<v_rd_off<NCB>(D0, 1, 0)>(vb), h1 = tr_read<v_rd_off<NCB>(D0, 1, 1)>(vb);
  const s16x4 l2 = tr_read<v_rd_off<NCB>(D0, 2, 0)>(vb), h2 = tr_read<v_rd_off<NCB>(D0, 2, 1)>(vb), l3 = tr_read<v_rd_off<NCB>(D0, 3, 0)>(vb), h3 = tr_read<v_rd_off<NCB>(D0, 3, 1)>(vb);
  asm volatile("s_waitcnt lgkmcnt(0)" ::: "memory"); SBAR();
#define PK(L, H) (bf16x8){L[0], L[1], L[2], L[3], H[0], H[1], H[2], H[3]}
  od = __builtin_amdgcn_mfma_f32_32x32x16_bf16(pa0, PK(l0, h0), od, 0, 0, 0);
  od = __builtin_amdgcn_mfma_f32_32x32x16_bf16(pa1, PK(l1, h1), od, 0, 0, 0);
  od = __builtin_amdgcn_mfma_f32_32x32x16_bf16(pa2, PK(l2, h2), od, 0, 0, 0);
  od = __builtin_amdgcn_mfma_f32_32x32x16_bf16(pa3, PK(l3, h3), od, 0, 0, 0);
#undef PK
}
template <int NCB> __device__ __forceinline__ void pv_all(f32x16* o, int vb, bf16x8 pa0, bf16x8 pa1, bf16x8 pa2, bf16x8 pa3) {
  pv_one<0, NCB>(o[0], vb, pa0, pa1, pa2, pa3); pv_one<1, NCB>(o[1], vb, pa0, pa1, pa2, pa3);
  if constexpr (NCB == 4) { pv_one<2, NCB>(o[2], vb, pa0, pa1, pa2, pa3); pv_one<3, NCB>(o[3], vb, pa0, pa1, pa2, pa3); }
}
struct Consts { const float* rel_bias; const float* sink; const float* lq1; const float* lk1; const float* lq2; const float* lk2; const float* subw; };

template <int MODE>
__device__ __forceinline__ void attn_unit(const bf16* __restrict__ P, bf16* __restrict__ CC, const Consts& cs, long rowbase, int S, int q0, int kt0, int NT, int hd, char* lds) {
  constexpr int DV = MODE == 0 ? 128 : 64, KW = MODE == 0 ? 128 : 64, NCB = DV / 32, NLD = MODE == 0 ? 2 : 1;
  constexpr int SHM_V = KVBLK * DV * 2, SHM_K = KVBLK * KW * 2;
  const int tid = threadIdx.x, lane = tid & 63, r32 = lane & 31, hi = lane >> 5;
  const int wid = __builtin_amdgcn_readfirstlane(tid >> 6), msel = wid >> 2, rg = wid & 3;
  char* V_lds = lds + L_V; char* K_lds = lds + L_K;
  float* wsf = (float*)(lds + L_WS) + wid * 64; float* li_l = wsf; float* al_l = wsf + 32;
  float* tabw = (float*)(lds + L_TAB);
  int qcol, kcol, vcol, gcol, ocol, kq, bcol;
  if constexpr (MODE == 0) { qcol = 1280 + hd * 128 + msel * 64; kcol = 1792 + hd * 128; vcol = 2304 + hd * 128; gcol = 2816 + hd * 128; ocol = 512 + hd * 128; kq = msel * 64; bcol = 8 + hd; }
  else { const int kvh = hd >> 1, qh = kvh * 4 + (hd & 1) * 2 + msel; qcol = qh * 64; kcol = 512 + kvh * 64; vcol = 640 + kvh * 64; gcol = 768 + qh * 64; ocol = qh * 64; kq = 0; bcol = qh; }
  if constexpr (MODE == 0) {
    for (int i = tid; i < 1024; i += 512) tabw[i] = 8.f * cs.rel_bias[t5_bucket(i - 512) * 12 + 8 + hd];
  } else {
    const int qh0 = (hd >> 1) * 4 + (hd & 1) * 2;
    for (int i = tid; i < 2048; i += 512) { const int rel = (i & 1023) - 512; const int a = rel < 0 ? -rel : rel;
      tabw[i] = a <= 128 ? 8.f * cs.rel_bias[t5_bucket(rel) * 12 + qh0 + (i >> 10)] : -1e30f; }
  }
  const float* tab = tabw + (MODE == 1 ? msel * 1024 : 0);
  float cLo = 0.f, cHi = 0.f;
  if constexpr (MODE == 0) { cLo = 8.f * cs.rel_bias[15 * 12 + bcol]; cHi = 8.f * cs.rel_bias[31 * 12 + bcol]; }
  float m_reg = -1e30f, l_reg = 0.f;
  if constexpr (MODE == 1) { m_reg = 8.f * cs.sink[bcol]; l_reg = 1.f; }
  f32x16 o[NCB];
#pragma unroll
  for (int d = 0; d < NCB; ++d) o[d] = f32x16{};
  bf16x8 qr[4];
  const int qw = q0 + rg * 32;
  const bf16* Qw = P + (size_t)(rowbase + qw + r32) * LDP + qcol + hi * 8;
#pragma unroll
  for (int d0 = 0; d0 < 4; ++d0) qr[d0] = *reinterpret_cast<const bf16x8*>(Qw + d0 * 16);
  const int sr = MODE == 0 ? (tid >> 4) : (tid >> 3), sc = MODE == 0 ? (tid & 15) * 8 : (tid & 7) * 8;
  const int kbase = kt0 * KVBLK;
  const bf16* Kg = P + (size_t)(rowbase + kbase + sr) * LDP + kcol + sc;
  const bf16* Vg = P + (size_t)(rowbase + kbase + sr) * LDP + vcol + sc;
  const int vst0 = v_st<NCB>(sr, sc), vst1 = v_st<NCB>(32 + sr, sc), kst0 = kswz<KW>(sr, sc * 2), kst1 = kswz<KW>(32 + sr, sc * 2);
  const int vb0 = (int)(uintptr_t)V_lds + v_rd_base(lane);
  struct { bf16x8 vs0, vs1, ks0, ks1; } sr_[2];
#define SLOAD(i, t) do { const size_t o_ = (size_t)(t) * KVBLK * LDP; sr_[i].vs0 = *reinterpret_cast<const bf16x8*>(Vg + o_); sr_[i].ks0 = *reinterpret_cast<const bf16x8*>(Kg + o_); \
    if constexpr (NLD == 2) { sr_[i].vs1 = *reinterpret_cast<const bf16x8*>(Vg + o_ + 32 * LDP); sr_[i].ks1 = *reinterpret_cast<const bf16x8*>(Kg + o_ + 32 * LDP); } } while (0)
#define SWRITE(b, i) do { *(bf16x8*)(V_lds + (b) * SHM_V + vst0) = sr_[i].vs0; *(bf16x8*)(K_lds + (b) * SHM_K + kst0) = sr_[i].ks0; \
    if constexpr (NLD == 2) { *(bf16x8*)(V_lds + (b) * SHM_V + vst1) = sr_[i].vs1; *(bf16x8*)(K_lds + (b) * SHM_K + kst1) = sr_[i].ks1; } } while (0)
#define SWAIT() do { if constexpr (NLD == 2) asm volatile("s_waitcnt vmcnt(4)" ::: "memory"); else asm volatile("s_waitcnt vmcnt(2)" ::: "memory"); } while (0)
#define RESC(a) do { if (__any((a) < 1.f)) { if (hi == 0) al_l[r32] = (a); asm volatile("s_waitcnt lgkmcnt(0)" ::: "memory"); \
    _Pragma("unroll") for (int d = 0; d < NCB; ++d) _Pragma("unroll") for (int r = 0; r < 16; ++r) o[d][r] *= al_l[crow(r, hi)]; } } while (0)
#define BIAS(P0, P1, t, CB) do { const int k0_ = kbase + (t) * KVBLK; \
    if (MODE == 1 || (k0_ > qw - 154 && k0_ < qw + 122)) { add_bias(P0, P1, tab, k0_ - qw - r32 + 4 * hi + 512); CB = 0.f; } \
    else CB = (k0_ < qw) ? cLo : cHi; } while (0)
  f32x16 pA0, pA1, pB0, pB1; float mnA, mnB, alA, alB, cbA, cbB; bf16x8 pa0, pa1, pa2, pa3;
  constexpr int SE = 0, SO = 1;
  SLOAD(SE, 0); asm volatile("s_waitcnt vmcnt(0)" ::: "memory"); SWRITE(0, SE); __syncthreads();
  qkt<KW>(pA0, pA1, K_lds, qr, r32, hi, kq); BIAS(pA0, pA1, 0, cbA); partialSM(pA0, pA1, m_reg, mnA, alA, cbA);
  SLOAD(SO, 1); if (2 < NT) SLOAD(SE, 2);
  SWAIT(); SWRITE(1, SO); __syncthreads();
  for (int j = 1; j + 1 < NT; j += 2) {
    SBAR(); qkt<KW>(pB0, pB1, K_lds + SHM_K, qr, r32, hi, kq);
    finishSM(pA0, pA1, alA, l_reg, pa0, pa1, pa2, pa3); SBAR();
    SLOAD(SO, j + 2); SBAR();
    pv_all<NCB>(o, vb0, pa0, pa1, pa2, pa3); BIAS(pB0, pB1, j, cbB); partialSM(pB0, pB1, m_reg, mnB, alB, cbB);
    __syncthreads(); SWAIT(); SWRITE(0, SE);
    RESC(alB); __syncthreads();
    SBAR(); qkt<KW>(pA0, pA1, K_lds, qr, r32, hi, kq);
    finishSM(pB0, pB1, alB, l_reg, pa0, pa1, pa2, pa3); SBAR();
    if (j + 3 < NT) SLOAD(SE, j + 3); SBAR();
    pv_all<NCB>(o, vb0 + SHM_V, pa0, pa1, pa2, pa3); BIAS(pA0, pA1, j + 1, cbA); partialSM(pA0, pA1, m_reg, mnA, alA, cbA);
    __syncthreads(); SWAIT(); SWRITE(1, SO);
    RESC(alA); __syncthreads();
  }
  SBAR(); qkt<KW>(pB0, pB1, K_lds + SHM_K, qr, r32, hi, kq);
  finishSM(pA0, pA1, alA, l_reg, pa0, pa1, pa2, pa3); SBAR();
  pv_all<NCB>(o, vb0, pa0, pa1, pa2, pa3); BIAS(pB0, pB1, NT - 1, cbB); partialSM(pB0, pB1, m_reg, mnB, alB, cbB);
  __syncthreads(); RESC(alB);
  finishSM(pB0, pB1, alB, l_reg, pa0, pa1, pa2, pa3); SBAR();
  pv_all<NCB>(o, vb0 + SHM_V, pa0, pa1, pa2, pa3);
  if (hi == 0) li_l[r32] = l_reg; asm volatile("s_waitcnt lgkmcnt(0)" ::: "memory");
  float rli[16];
#pragma unroll
  for (int r = 0; r < 16; ++r) rli[r] = __builtin_amdgcn_rcpf(li_l[crow(r, hi)]);
  const size_t trow = (size_t)(rowbase + qw);
  if constexpr (MODE == 1) {
#pragma unroll
    for (int r = 0; r < 16; ++r) { const size_t row = trow + crow(r, hi);
#pragma unroll
      for (int d0 = 0; d0 < NCB; ++d0) { const int col = d0 * 32 + r32; const float g = bf2f(P[row * LDP + gcol + col]); CC[row * DM + ocol + col] = f2bf(o[d0][r] * rli[r] * g); } }
    __syncthreads();
  } else {
    float* X = (float*)lds;
    __syncthreads();
    if (msel == 1) {
#pragma unroll
      for (int r = 0; r < 16; ++r)
#pragma unroll
        for (int d0 = 0; d0 < NCB; ++d0) X[(rg * 32 + crow(r, hi)) * 128 + d0 * 32 + r32] = o[d0][r] * rli[r];
    }
    float s1 = cs.lq1[lane] * cs.lk1[lane], s2 = cs.lq2[lane] * cs.lk2[lane];
#pragma unroll
    for (int of = 1; of < 64; of <<= 1) { s1 += __shfl_xor(s1, of); s2 += __shfl_xor(s2, of); }
    const float lam = __expf(s1) - __expf(s2) + LAMBDA_INIT;
    __syncthreads();
    if (msel == 0) {
      float rn[16];
#pragma unroll
      for (int r = 0; r < 16; ++r) { float ss = 0.f;
#pragma unroll
        for (int d0 = 0; d0 < NCB; ++d0) { const float d = o[d0][r] * rli[r] - lam * X[(rg * 32 + crow(r, hi)) * 128 + d0 * 32 + r32]; o[d0][r] = d; ss += d * d; }
        ss += __shfl_xor(ss, 1); ss += __shfl_xor(ss, 2); ss += __shfl_xor(ss, 4); ss += __shfl_xor(ss, 8); ss += __shfl_xor(ss, 16);
        rn[r] = __builtin_amdgcn_rsqf(ss * (1.f / 128.f) + SUBLN_EPS) * (1.f - LAMBDA_INIT); }
      float sw[NCB];
#pragma unroll
      for (int d0 = 0; d0 < NCB; ++d0) sw[d0] = cs.subw[d0 * 32 + r32];
#pragma unroll
      for (int r = 0; r < 16; ++r) { const size_t row = trow + crow(r, hi);
#pragma unroll
        for (int d0 = 0; d0 < NCB; ++d0) { const int col = d0 * 32 + r32; const float g = bf2f(P[row * LDP + gcol + col]); CC[row * DM + ocol + col] = f2bf(o[d0][r] * rn[r] * sw[d0] * g); } }
    }
    __syncthreads();
  }
#undef SLOAD
#undef SWRITE
#undef SWAIT
#undef RESC
#undef BIAS
}
#undef SBAR
}

constexpr int NWAVES = 8;
constexpr size_t MiB = 1u << 20;
constexpr size_t WS_CTL = 0, CTL_ZERO_BYTES = 1 * MiB;
constexpr size_t WS_WIN = 2 * MiB;
constexpr size_t WS_WOUT = 9 * MiB;
constexpr size_t WS_MOD = 11 * MiB;
constexpr size_t WS_U = 16 * MiB;
constexpr size_t WS_PROJ = 112 * MiB;
constexpr size_t WS_END = 424 * MiB;
constexpr int CW_TMO = 0, CW_CODE = 1, CW_BAR = 4096;
constexpr int RING_OFF = 0, RING_BYTES = 131072;
constexpr int LDSCTL_OFF = RING_BYTES, MISC_OFF = LDSCTL_OFF + 320;
constexpr int LDS_BYTES = 147456;
static_assert(att::L_END <= RING_BYTES, "attention scratch inside the ring");

#define GAS __attribute__((address_space(1)))
#define LAS __attribute__((address_space(3)))
typedef unsigned short bf16;
typedef unsigned v4u __attribute__((ext_vector_type(4)));
typedef float f32x4 __attribute__((ext_vector_type(4)));
typedef GAS unsigned gu32;
#define RLX_AGENT __ATOMIC_RELAXED, __HIP_MEMORY_SCOPE_AGENT
#define LDS_WAIT() asm volatile("s_waitcnt lgkmcnt(0)" ::: "memory")
#define VM_WAIT() asm volatile("s_waitcnt vmcnt(0)" ::: "memory")
__device__ __forceinline__ unsigned f2bf(float f) { unsigned u = __builtin_bit_cast(unsigned, f); return (u + 0x7fffu + ((u >> 16) & 1u)) >> 16; }
__device__ __forceinline__ unsigned pk2(float lo, float hi) { return f2bf(lo) | (f2bf(hi) << 16); }

#define XB_TMO      128
#define XB_XCNT(j)  (256  + 64 * (j))
#define XB_XSUB(j)  (1280 + 64 * (j))
#define XB_XGEN(j)  (2304 + 64 * (j))
#define XB_TOP      3328
#define XB_TOPGEN   3392
#define XCD_BAR_WORDS 3456
#define XB_SPIN_CAP (1u << 18)

__device__ __forceinline__ unsigned xb_ld(unsigned* p)              { return __hip_atomic_load(p, __ATOMIC_RELAXED, __HIP_MEMORY_SCOPE_AGENT); }
__device__ __forceinline__ unsigned xb_add(unsigned* p, unsigned v) { return __hip_atomic_fetch_add(p, v, __ATOMIC_RELAXED, __HIP_MEMORY_SCOPE_AGENT); }
__device__ __forceinline__ unsigned xb_xcc_id() { return (unsigned)__builtin_amdgcn_s_getreg((3 << 11) | 20) & 0xFu; }
#define XB_SPIN(cond, bar) do { unsigned _sp = 0; while (cond) { __builtin_amdgcn_s_sleep(1); \
    if ((++_sp & 255u) == 0u) { if (xb_ld(&(bar)[XB_TMO])) break; if (_sp > XB_SPIN_CAP) { atomicAdd(&(bar)[XB_TMO], 1u); break; } } } } while (0)

struct XcdBarrier {
    unsigned* bar; unsigned x;
    volatile LAS unsigned* st;
};

__device__ __forceinline__ XcdBarrier xcd_barrier_post(unsigned* bar, volatile LAS unsigned* st) {
    XcdBarrier b; b.bar = bar; b.x = xb_xcc_id(); b.st = st;
    if (threadIdx.x == 0) (void)xb_add(&bar[XB_XCNT(b.x)], 1u);
    return b;
}
__device__ __forceinline__ void xcd_barrier_complete(unsigned* bar, unsigned x, unsigned& nloc, unsigned& nx) {
    const unsigned G = gridDim.x * gridDim.y * gridDim.z;
    unsigned sum, cnt, mine, sp = 0u;
    for (;;) {
        sum = 0u; cnt = 0u; mine = 0u;
#pragma unroll
        for (unsigned j = 0; j < 16; ++j) { const unsigned c = xb_ld(&bar[XB_XCNT(j)]); sum += c; cnt += (c > 0u) ? 1u : 0u; mine = (j == x) ? c : mine; }
        if (sum == G) break;
        __builtin_amdgcn_s_sleep(1);
        if ((++sp & 255u) == 0u) { if (xb_ld(&bar[XB_TMO])) break; if (sp > XB_SPIN_CAP) { atomicAdd(&bar[XB_TMO], 1u); break; } }
    }
    nloc = mine > 0u ? mine : 1u; nx = cnt > 0u ? cnt : 1u;
}

__device__ __forceinline__ void xcd_barrier(const XcdBarrier& b) {
    asm volatile("s_waitcnt vmcnt(0)" ::: "memory");
    __syncthreads();
    if (threadIdx.x == 0) {
        unsigned* bar = b.bar;
        __builtin_amdgcn_s_waitcnt(0);
        unsigned nloc = b.st[0], nx = b.st[1];
        if (nloc == 0u) { xcd_barrier_complete(bar, b.x, nloc, nx); b.st[0] = nloc; b.st[1] = nx; }
        const unsigned old = xb_add(&bar[XB_XSUB(b.x)], 1u);
        const unsigned gen = old / nloc;
        if (old + 1u == (gen + 1u) * nloc) {
            __builtin_amdgcn_fence(__ATOMIC_RELEASE, "agent");
            asm volatile("s_waitcnt vmcnt(0)" ::: "memory");
            const unsigned og = xb_add(&bar[XB_TOP], 1u);
            const unsigned tg = og / nx;
            if (og + 1u == (tg + 1u) * nx) xb_add(&bar[XB_TOPGEN], 1u);
            else XB_SPIN(xb_ld(&bar[XB_TOPGEN]) == tg, bar);
            __builtin_amdgcn_fence(__ATOMIC_ACQUIRE, "agent");
            xb_add(&bar[XB_XGEN(b.x)], 1u);
            asm volatile("s_waitcnt vmcnt(0)" ::: "memory");
        } else {
            XB_SPIN(xb_ld(&bar[XB_XGEN(b.x)]) == gen, bar);
            __builtin_amdgcn_fence(__ATOMIC_ACQUIRE, "agent");
            asm volatile("s_waitcnt vmcnt(0)" ::: "memory");
        }
    }
    __syncthreads();
}
struct Frame {
    LAS unsigned char* lds;
    volatile LAS unsigned* MISC;
    gu32* ctl;
    int tid, lane, wave;
    int vcu, G;
    const float *xp, *xs, *cp, *cs, *w_in, *w_out, *w_ada, *b_ada, *ln_g, *ln_b;
    float* out;
    bf16 *Win_t, *Wout_t, *U, *PROJ;
    float* MOD;
};
__device__ __forceinline__ float wave_sum(float v) {
#pragma unroll
    for (int o = 1; o < 64; o <<= 1) v += __shfl_xor(v, o);
    return v;
}
__device__ __forceinline__ void p0_transpose_item(const float* W, int K, int N, bf16* WT, int row_off, LAS float* scr, int item, int lane) {
    const int nblk = N / 32, kb = item / nblk, nb = item % nblk, k0 = 64 * kb, n0 = 32 * nb;
#pragma unroll 8
    for (int i = 0; i < 32; ++i) { const int kk = 2 * i + (lane >> 5); scr[kk * 33 + (lane & 31)] = W[(size_t)(k0 + kk) * N + n0 + (lane & 31)]; }
    LDS_WAIT(); asm volatile("" ::: "memory");
    const int c = lane & 7;
#pragma unroll
    for (int j = 0; j < 4; ++j) { const int n = (lane >> 3) + 8 * j; const LAS float* s = scr + (8 * c) * 33 + n;
        v4u o; o.x = pk2(s[0 * 33], s[1 * 33]); o.y = pk2(s[2 * 33], s[3 * 33]); o.z = pk2(s[4 * 33], s[5 * 33]); o.w = pk2(s[6 * 33], s[7 * 33]);
        *(GAS v4u*)(WT + (size_t)(row_off + n0 + n) * K + k0 + 8 * c) = o; }
    LDS_WAIT(); asm volatile("" ::: "memory");
}
__device__ __forceinline__ void p0_prologue(Frame& F) {
    LAS float* scr = (LAS float*)(F.lds + RING_OFF + F.wave * 16384);
    const int gw = F.vcu * NWAVES + F.wave, NGW = F.G * NWAVES;
    constexpr int I_IN = (DM / 64) * (DIN / 32), I_OUT = (DM / 64) * (DM / 32);
    for (int it = gw; it < I_IN + I_OUT; it += NGW) {
        if (it < I_IN) p0_transpose_item(F.w_in, DM, DIN, F.Win_t, 0, scr, it, F.lane);
        else p0_transpose_item(F.w_out, DM, DM, F.Wout_t, 0, scr, it - I_IN, F.lane);
    }
    __syncthreads();
    constexpr int NITEM = 3072 / 16;
    if (F.vcu * NWAVES < NITEM) {
        LAS float* sc = (LAS float*)(F.lds + RING_OFF);
        for (int i = F.tid; i < 12 * 1024; i += NWAVES * 64) { const int k = i / 12, b = i - k * 12; float v = 0.f;
            if (b < 8) v = silu_f(F.cp[b * 1024 + k]); else if (b < 10) v = silu_f(F.cs[(b - 8) * 1024 + k]);
            sc[i] = v; }
        __syncthreads();
        for (int it = gw; it < NITEM; it += NGW) {
            const int n0 = it * 16, col = F.lane & 15, kg = F.lane >> 4;
            float acc[12];
#pragma unroll
            for (int b = 0; b < 12; ++b) acc[b] = 0.f;
#pragma unroll 4
            for (int i = 0; i < 256; ++i) { const int k = 4 * i + kg; const float w = F.w_ada[(size_t)k * 3072 + n0 + col];
                const f32x4 s0 = *(const LAS f32x4*)(sc + k * 12), s1 = *(const LAS f32x4*)(sc + k * 12 + 4), s2 = *(const LAS f32x4*)(sc + k * 12 + 8);
                acc[0] += s0[0] * w; acc[1] += s0[1] * w; acc[2] += s0[2] * w; acc[3] += s0[3] * w; acc[4] += s1[0] * w; acc[5] += s1[1] * w;
                acc[6] += s1[2] * w; acc[7] += s1[3] * w; acc[8] += s2[0] * w; acc[9] += s2[1] * w; }
#pragma unroll
            for (int b = 0; b < 10; ++b) { acc[b] += __shfl_xor(acc[b], 16); acc[b] += __shfl_xor(acc[b], 32); }
            if (F.lane < 16) { const int n = n0 + F.lane; const float add = F.b_ada[n] + ((n >= 1024 && n < 2048) ? 1.f : 0.f);
#pragma unroll
                for (int b = 0; b < 10; ++b) F.MOD[b * 3072 + n] = acc[b] + add; }
        }
    }
}
__device__ __forceinline__ void p1_modulate(Frame& F) {
    const int gw = F.vcu * NWAVES + F.wave, NGW = F.G * NWAVES;
    for (int m = gw; m < NTOK; m += NGW) {
        const int b = tok_batch(m);
        const float* xrow = m < NPROMPT ? F.xp + (size_t)m * DM : F.xs + (size_t)(m - NPROMPT) * DM;
        const GAS f32x4* xr = (const GAS f32x4*)xrow + F.lane;
        const GAS f32x4* sh = (const GAS f32x4*)(F.MOD + b * 3072) + F.lane; const GAS f32x4* scl = (const GAS f32x4*)(F.MOD + b * 3072 + 1024) + F.lane;
        GAS unsigned long long* o8 = (GAS unsigned long long*)(F.U + (size_t)m * DM) + F.lane;
#pragma unroll
        for (int j = 0; j < 4; ++j) { const f32x4 v = xr[64 * j] * scl[64 * j] + sh[64 * j];
            o8[64 * j] = (unsigned long long)pk2(v.x, v.y) | ((unsigned long long)pk2(v.z, v.w) << 32); }
    }
}
__device__ __forceinline__ void p5_layernorm(Frame& F) {
    const int gw = F.vcu * NWAVES + F.wave, NGW = F.G * NWAVES;
    f32x4 gg[4], bb[4];
#pragma unroll
    for (int j = 0; j < 4; ++j) { gg[j] = ((const GAS f32x4*)F.ln_g)[F.lane + 64 * j]; bb[j] = ((const GAS f32x4*)F.ln_b)[F.lane + 64 * j]; }
    for (int m = gw; m < NTOK; m += NGW) {
        GAS f32x4* p = (GAS f32x4*)(F.out + (size_t)m * DM) + F.lane;
        f32x4 v[4]; float s = 0.f;
#pragma unroll
        for (int j = 0; j < 4; ++j) { v[j] = p[64 * j]; s += (v[j].x + v[j].y) + (v[j].z + v[j].w); }
        const float mean = wave_sum(s) * (1.f / DM); float s2 = 0.f;
#pragma unroll
        for (int j = 0; j < 4; ++j) { v[j] = v[j] - mean; s2 += (v[j].x * v[j].x + v[j].y * v[j].y) + (v[j].z * v[j].z + v[j].w * v[j].w); }
        const float rstd = 1.f / sqrtf(wave_sum(s2) * (1.f / DM) + LN_EPS);
#pragma unroll
        for (int j = 0; j < 4; ++j) p[64 * j] = v[j] * rstd * gg[j] + bb[j];
    }
}

struct Args { const float* in[17]; float* out; unsigned char* ws; int ph_lo, ph_hi, li, pad; };
__global__ void __launch_bounds__(NWAVES * 64, 2) mega_fwd(Args args) {
    extern __shared__ __attribute__((aligned(16))) unsigned char lds[];
    Frame F;
    F.lds = (LAS unsigned char*)lds;
    F.MISC = (volatile LAS unsigned*)(F.lds + MISC_OFF);
    F.tid = threadIdx.x; F.lane = F.tid & 63; F.wave = __builtin_amdgcn_readfirstlane(F.tid >> 6);
    F.G = gridDim.x; { const int bx = blockIdx.x; F.vcu = (F.G % 8 == 0) ? (bx % 8) * (F.G / 8) + bx / 8 : bx; }
#define GRID_BAR(seam) do { if (N_LAUNCHES == PER_PHASE) { if (F.tid == 0) __hip_atomic_store(F.ctl + CW_TMO, 0xBADBA0u | (unsigned)(seam), RLX_AGENT); } \
    else { xcd_barrier(bar); } } while (0)
    unsigned char* ws = args.ws;
    F.ctl = (gu32*)(ws + WS_CTL);
    F.xp = args.in[0]; F.xs = args.in[1]; F.cp = args.in[2]; F.cs = args.in[3]; F.w_in = args.in[4]; F.w_out = args.in[5]; F.w_ada = args.in[6]; F.b_ada = args.in[7];
    F.ln_g = args.in[8]; F.ln_b = args.in[9]; F.out = args.out;
    F.Win_t = (bf16*)(ws + WS_WIN); F.Wout_t = (bf16*)(ws + WS_WOUT); F.U = (bf16*)(ws + WS_U); F.PROJ = (bf16*)(ws + WS_PROJ); F.MOD = (float*)(ws + WS_MOD);
    for (int u = F.tid; u < (LDS_BYTES - LDSCTL_OFF) / 4; u += NWAVES * 64) ((LAS unsigned*)(F.lds + LDSCTL_OFF))[u] = 0u;
    __syncthreads();
    XcdBarrier bar; bar.bar = (unsigned*)(F.ctl + CW_BAR); bar.x = 0; bar.st = nullptr;
    if (N_LAUNCHES != PER_PHASE) bar = xcd_barrier_post((unsigned*)(F.ctl + CW_BAR), F.MISC + 8);
    const int lo = args.ph_lo, hi = args.ph_hi;
#define IN(k) (lo <= (k) && (k) < hi)
#define BOTH(k) (IN(k) && IN((k) + 1))
    if (IN(0)) { p0_prologue(F); if (BOTH(0)) GRID_BAR(0); }
    if (IN(1)) { p1_modulate(F); if (BOTH(1)) GRID_BAR(1); }
    if (IN(2)) {
        pg8::Gemm g{F.U, F.Win_t, NTOK, DIN, DM}; pg8::StaticOrder S; S.init(NTOK, DIN, F.G, (int)blockIdx.x);
        pg8::EpiProj E{F.PROJ, DIN};
        pg8::gemm_phase<pg8::EpiProj, pg8::StaticOrder, PG8_ALIGN, PG8_SP2>(F.lds + RING_OFF, g, S, E);
        if (BOTH(2)) GRID_BAR(2);
    }
    if (IN(3)) {
        const att::Consts cs{args.in[16], args.in[10], args.in[11], args.in[12], args.in[13], args.in[14], args.in[15]};
        const att::bf16* P = (const att::bf16*)F.PROJ; att::bf16* CC = (att::bf16*)F.U;
        char* al = (char*)lds + RING_OFF;
        for (int s = F.vcu; s < 512; s += F.G) {
            const int v = s & 255, bh = v >> 5, qt = (v & 31) + 32 * (s >> 8);
            att::attn_unit<0>(P, CC, cs, (long)NPROMPT + (long)(bh >> 2) * SEQ_S, SEQ_S, qt * 128, 0, SEQ_S / 64, bh & 3, al);
        }
        for (int s = F.vcu; s < 1024; s += F.G) {
            const int v = s & 255, bh = (v >> 5) * 4 + (s >> 8), qt = v & 31;
            att::attn_unit<0>(P, CC, cs, (long)(bh >> 2) * SEQ_P, SEQ_P, qt * 128, 0, SEQ_P / 64, bh & 3, al);
        }
        for (int s = F.vcu; s < 1536; s += F.G) {
            const int v = s & 255, uid = v * 6 + (s >> 8), blk = uid >> 2, hd = uid & 3;
            long rowbase; int S, qb;
            if (blk < 256) { rowbase = (long)(blk >> 5) * SEQ_P; S = SEQ_P; qb = blk & 31; }
            else { const int bb = blk - 256; rowbase = (long)NPROMPT + (long)(bb >> 6) * SEQ_S; S = SEQ_S; qb = bb & 63; }
            const int q0 = qb * 128, klo = q0 - 128 < 0 ? 0 : q0 - 128, khi = q0 + 256 > S ? S : q0 + 256;
            att::attn_unit<1>(P, CC, cs, rowbase, S, q0, klo / 64, (khi - klo) / 64, hd, al);
        }
        if (BOTH(3)) GRID_BAR(3);
    }
    if (IN(4)) {
        pg8::Gemm g{F.U, F.Wout_t, NTOK, DM, DM}; pg8::StaticOrder S; S.init(NTOK, DM, F.G, (int)blockIdx.x);
        pg8::EpiResid E{F.xp, F.xs, F.MOD, F.out};
        pg8::gemm_phase<pg8::EpiResid, pg8::StaticOrder, PG8_ALIGN, PG8_SP2>(F.lds + RING_OFF, g, S, E);
        if (BOTH(4)) GRID_BAR(4);
    }
    if (IN(5)) { p5_layernorm(F); }
#undef IN
#undef BOTH
}

extern "C" void kernel_launch(void* const* d_in, const int* in_sizes, int n_in, void* d_out, int out_size, void* d_ws, size_t ws_size, hipStream_t stream) {
    static int grid = 0;
    if (grid == 0) {
        if (n_in != 17 || out_size != NTOK * DM || ws_size < WS_END) { fprintf(stderr, "kernel_launch: unexpected shapes (n_in %d out %d ws %zu); nothing launched\n", n_in, out_size, ws_size); grid = -1; return; }
        int dev = 0, cus = 0, per_cu = 0;
        if (hipGetDevice(&dev) != hipSuccess || hipDeviceGetAttribute(&cus, hipDeviceAttributeMultiprocessorCount, dev) != hipSuccess) { fprintf(stderr, "kernel_launch: device query failed\n"); grid = -1; return; }
        if (hipFuncSetAttribute((const void*)mega_fwd, hipFuncAttributeMaxDynamicSharedMemorySize, LDS_BYTES) != hipSuccess) { fprintf(stderr, "kernel_launch: hipFuncSetAttribute failed\n"); grid = -1; return; }
        if (hipOccupancyMaxActiveBlocksPerMultiprocessor(&per_cu, (const void*)mega_fwd, NWAVES * 64, LDS_BYTES) != hipSuccess || per_cu < 1)
            fprintf(stderr, "kernel_launch: note: occupancy query reports %d workgroups per CU\n", per_cu);
        (void)hipGetLastError();
        grid = cus;
    }
    if (grid < 0) return;
    if (hipMemsetAsync((char*)d_ws + WS_CTL, 0, CTL_ZERO_BYTES, stream) != hipSuccess) { fprintf(stderr, "kernel_launch: hipMemsetAsync failed\n"); return; }
    Args a{};
    for (int i = 0; i < 17; ++i) a.in[i] = (const float*)d_in[i];
    a.out = (float*)d_out; a.ws = (unsigned char*)d_ws;
    for (int li = 0; li < N_LAUNCHES; ++li) {
        a.ph_lo = (N_LAUNCHES == PER_PHASE) ? li : 0; a.ph_hi = (N_LAUNCHES == PER_PHASE) ? li + 1 : PER_PHASE; a.li = li;
        hipLaunchKernelGGL(mega_fwd, dim3(grid), dim3(NWAVES * 64), LDS_BYTES, stream, a);
        const hipError_t le = hipPeekAtLastError();
        if (le != hipSuccess) { fprintf(stderr, "kernel_launch: launch %d failed: %s\n", li, hipGetErrorName(le)); break; }
    }
}
```

```cpp
#include <hip/hip_runtime.h>
#include <cstdio>
#include <cstdint>

#ifndef MK_N_LAUNCHES
#define MK_N_LAUNCHES 1
#endif
constexpr int N_LAUNCHES = MK_N_LAUNCHES;
constexpr int PER_PHASE = 6;

constexpr int DM = 1024, NTOK = 49152, NPROMPT = 32768, DIN = 3328, SEQ_P = 4096, SEQ_S = 8192;
constexpr float ALPHA = 1.189207115002721f;
constexpr float LN_EPS = 1e-5f, SUBLN_EPS = 1e-5f, LAMBDA_INIT = 0.2f;
__device__ __forceinline__ int tok_batch(int m) { return m < NPROMPT ? (m >> 12) : 8 + ((m - NPROMPT) >> 13); }
__device__ __forceinline__ int t5_bucket(int rel) {
    const int n = rel < 0 ? -rel : rel;
    const int b = n < 8 ? n : n < 12 ? 8 : n < 16 ? 9 : n < 23 ? 10 : n < 32 ? 11 : n < 46 ? 12 : n < 64 ? 13 : n < 91 ? 14 : 15;
    return b + (rel > 0 ? 16 : 0);
}
__device__ __forceinline__ int fresh_tid() { int t = threadIdx.x; asm volatile("" : "+v"(t)); return t; }
__device__ __forceinline__ float silu_f(float x) { return x * __builtin_amdgcn_rcpf(1.f + __builtin_amdgcn_exp2f(-1.4426950408889634f * x)); }

namespace pg8 {
#define PG8_LAS __attribute__((address_space(3)))
typedef unsigned short bf16_t;
typedef short bf16x8 __attribute__((ext_vector_type(8)));
typedef float f32x4 __attribute__((ext_vector_type(4)));
typedef unsigned u32x4 __attribute__((ext_vector_type(4)));
constexpr int BM = 256, BK = 64, HALF = 128, HTB = HALF * BK * 2  , STAGE_BYTES = 8 * HTB, NXCD = 8, WGM = 8;

__host__ __device__ __forceinline__ int lds_byte(int r, int c) { const int st = (r >> 4) * 2 + (c >> 5), rr = r & 15, cc = c & 31, ob = rr * 64 + cc * 2; return st * 1024 + (ob ^ (((ob >> 9) & 1) << 5)); }
__host__ __device__ __forceinline__ void stage_rc(int b, int& R, int& C) { const int st = b / 1024, sb = b % 1024, swz = sb ^ (((sb >> 9) & 1) << 5); R = (st >> 1) * 16 + swz / 64; C = (st & 1) * 32 + (swz % 64) / 2; }
__host__ __device__ __forceinline__ int perm32(int rho) { const int n = rho >> 4, i = rho & 15; return 8 * (i >> 2) + 4 * n + (i & 3); }

struct Unit { int pm, pn; };
struct Gemm { const bf16_t* A; const bf16_t* Bt; int M, N, K; };

struct StaticOrder {
    int nM, nN, nwg, G, c;
    __host__ __device__ void init(int M, int N, int G_, int c_) { nM = M / BM; nN = N / BM; nwg = nM * nN; G = G_; c = c_; }
    __host__ __device__ bool next(int i, Unit& u) const {
        const long L = (long)i * G + c; if (L >= nwg) return false;
        int wgid = (int)L; { const int q = nwg / NXCD, r = nwg % NXCD, xcd = wgid % NXCD, off = wgid / NXCD; wgid = (xcd < r ? xcd * (q + 1) : r * (q + 1) + (xcd - r) * q) + off; }
        const int nig = WGM * nN, gid = wgid / nig, fm = gid * WGM, gsz = (nM - fm) < WGM ? (nM - fm) : WGM;
        u.pm = fm + ((wgid % nig) % gsz); u.pn = (wgid % nig) / gsz; return true;
    }
    __device__ __forceinline__ void a_ready(const Unit&) const {}
    __device__ __forceinline__ void done(const Unit&) const {}
};

__device__ __forceinline__ unsigned cvt_pk_bf16(float lo, float hi) { unsigned r; asm volatile("v_cvt_pk_bf16_f32 %0, %1, %2" : "=v"(r) : "v"(lo), "v"(hi)); return r; }
struct EpiProj {
    static constexpr bool PERM = true, AFTER_DRAIN = false;
    bf16_t* O; int ldc; float qscale;
    __device__ __forceinline__ void operator()(const f32x4 (&acc)[2][2][4][2], const Unit& u, int wr, int wc, int fr, int fq) const {
        const int row0 = u.pm * BM + wr * 64 + fr, col0 = u.pn * BM + wc * 32 + 8 * fq;
        const bool act = (u.pn == 3 || u.pn == 4 || u.pn == 11 || u.pn == 12);
        const float sc = (u.pn == 0 || u.pn == 1 || u.pn == 5 || u.pn == 6) ? qscale : 1.f;
#pragma unroll
        for (int ai = 0; ai < 2; ++ai)
#pragma unroll
            for (int m = 0; m < 4; ++m) { bf16_t* rowp = O + (size_t)(row0 + ai * HALF + m * 16) * ldc + col0;
#pragma unroll
                for (int bj = 0; bj < 2; ++bj) { f32x4 v0 = acc[ai][bj][m][0], v1 = acc[ai][bj][m][1];
                    if (act) { v0 = (f32x4){silu_f(v0[0]), silu_f(v0[1]), silu_f(v0[2]), silu_f(v0[3])}; v1 = (f32x4){silu_f(v1[0]), silu_f(v1[1]), silu_f(v1[2]), silu_f(v1[3])}; }
                    v0 = v0 * sc; v1 = v1 * sc;
                    u32x4 w; w.x = cvt_pk_bf16(v0[0], v0[1]); w.y = cvt_pk_bf16(v0[2], v0[3]); w.z = cvt_pk_bf16(v1[0], v1[1]); w.w = cvt_pk_bf16(v1[2], v1[3]);
                    *(u32x4*)(rowp + bj * HALF) = w; } }
    }
};
struct EpiResid {
    static constexpr bool PERM = false, AFTER_DRAIN = false;
    const float* xp; const float* xs; const float* mod; float* out;
    __device__ __forceinline__ void operator()(const f32x4 (&acc)[2][2][4][2], const Unit& u, int wr, int wc, int fr, int fq) const {
        const int rowt = u.pm * BM; const int b = tok_batch(rowt);
        const float* gate = mod + b * 3072 + 2048;
        const float* xb = rowt < NPROMPT ? xp + (size_t)rowt * DM : xs + (size_t)(rowt - NPROMPT) * DM;
        const int col0 = u.pn * BM + wc * 32 + 4 * fq;
        f32x4 gv[2][2];
#pragma unroll
        for (int bj = 0; bj < 2; ++bj)
#pragma unroll
            for (int n = 0; n < 2; ++n) gv[bj][n] = *(const f32x4*)(gate + col0 + bj * HALF + n * 16);
#pragma unroll
        for (int ai = 0; ai < 2; ++ai)
#pragma unroll
            for (int m = 0; m < 4; ++m) { const int r = ai * HALF + wr * 64 + m * 16 + fr; const size_t off = (size_t)r * DM + col0;
#pragma unroll
                for (int bj = 0; bj < 2; ++bj)
#pragma unroll
                    for (int n = 0; n < 2; ++n) { const f32x4 xv = *(const f32x4*)(xb + off + bj * HALF + n * 16);
                        *(f32x4*)(out + (size_t)rowt * DM + off + bj * HALF + n * 16) = xv * ALPHA + gv[bj][n] * acc[ai][bj][m][n]; }
                if (m & 1) asm volatile("" ::: "memory"); }
    }
};

template <class Epi, class Sched, bool ALIGN_EPI = false, bool SP2 = false>
__device__ __forceinline__ void gemm_phase(PG8_LAS unsigned char* lds, const Gemm g, const Sched& S, const Epi& E) {
    const int tid = fresh_tid(), wid = __builtin_amdgcn_readfirstlane(tid >> 6), lane = tid & 63, wr = wid >> 2, wc = wid & 3, fr = lane & 15, fq = lane >> 4;
    const int K = g.K, nt = K / BK;
    unsigned voffA[2], voffB[2];
#pragma unroll
    for (int i = 0; i < 2; ++i) { int R, C; stage_rc(tid * 16 + i * 8192, R, C); const int Rb = Epi::PERM ? ((R & ~31) + perm32(R & 31)) : R;
        voffA[i] = (unsigned)(R * K + C) * 2u; voffB[i] = (unsigned)(Rb * K + C) * 2u; }
    const size_t kstep = (size_t)(BK * 2);
    const size_t hstep = (size_t)HALF * K * 2;
    const size_t tstep = 2 * hstep;
    const unsigned ldsw = (unsigned)wid * 1024u;
    const int aoff = lds_byte(wr * 64 + fr, fq * 8), boff = lds_byte(wc * 32 + fr, fq * 8);
#define PG8_SA(b, h) (((b) * 2 + (h)) * HTB)
#define PG8_SB(b, h) ((4 + (b) * 2 + (h)) * HTB)
#define PG8_STAGE(bufoff, gbase, voff) do { _Pragma("unroll") for (int _i = 0; _i < 2; ++_i) \
        __builtin_amdgcn_global_load_lds((const unsigned*)((const char*)(gbase) + (voff)[_i]), (PG8_LAS unsigned*)(lds + (bufoff) + ldsw + _i * 8192), 16, 0, 0); } while (0)
#define PG8_LDA(dst, b, h) do { _Pragma("unroll") for (int m = 0; m < 4; ++m) _Pragma("unroll") for (int k = 0; k < 2; ++k) dst[m][k] = *(const PG8_LAS bf16x8*)(lds + PG8_SA(b, h) + aoff + m * 2048 + k * 1024); } while (0)
#define PG8_LDB(dst, b, h) do { _Pragma("unroll") for (int n = 0; n < 2; ++n) _Pragma("unroll") for (int k = 0; k < 2; ++k) dst[n][k] = *(const PG8_LAS bf16x8*)(lds + PG8_SB(b, h) + boff + n * 2048 + k * 1024); } while (0)
#define PG8_MMA(ai, bj, At, Bt) do { __builtin_amdgcn_s_setprio(1); _Pragma("unroll") for (int m = 0; m < 4; ++m) _Pragma("unroll") for (int n = 0; n < 2; ++n) _Pragma("unroll") for (int k = 0; k < 2; ++k) \
        acc[ai][bj][m][n] = __builtin_amdgcn_mfma_f32_16x16x32_bf16(Bt[n][k], At[m][k], acc[ai][bj][m][n], 0, 0, 0); __builtin_amdgcn_s_setprio(0); } while (0)
#define PG8_WAIT_V(n) asm volatile("s_waitcnt vmcnt(" #n ")" ::: "memory")
#define PG8_WAIT_L(n) asm volatile("s_waitcnt lgkmcnt(" #n ")" ::: "memory")
#define PG8_BAR __builtin_amdgcn_s_barrier()
#define PG8_SCHED __builtin_amdgcn_sched_barrier(0)
    Unit cur, nxt; int ui = 0;
    if (!S.next(0, cur)) return;
    f32x4 acc[2][2][4][2];
#pragma unroll
    for (int a = 0; a < 2; ++a)
#pragma unroll
        for (int b = 0; b < 2; ++b)
#pragma unroll
            for (int m = 0; m < 4; ++m)
#pragma unroll
                for (int n = 0; n < 2; ++n) acc[a][b][m][n] = (f32x4){0.f, 0.f, 0.f, 0.f};
    bf16x8 At[4][2], B0[2][2], B1[2][2];
    const char* cA = (const char*)g.A + (size_t)cur.pm * tstep; const char* cB = (const char*)g.Bt + (size_t)cur.pn * tstep;
    S.a_ready(cur);
    if constexpr (SP2) {
        PG8_STAGE(PG8_SB(0, 0), cB, voffB); PG8_STAGE(PG8_SB(0, 1), cB + hstep, voffB); PG8_STAGE(PG8_SA(0, 0), cA, voffA); PG8_STAGE(PG8_SA(0, 1), cA + hstep, voffA);
        if (wr == 1) PG8_BAR;
        PG8_WAIT_V(2); PG8_BAR;
        PG8_STAGE(PG8_SB(1, 0), cB + kstep, voffB); PG8_STAGE(PG8_SA(1, 0), cA + kstep, voffA); PG8_STAGE(PG8_SB(1, 1), cB + hstep + kstep, voffB);
        PG8_WAIT_V(6); PG8_BAR;
    } else {
        PG8_STAGE(PG8_SB(0, 0), cB, voffB); PG8_STAGE(PG8_SA(0, 0), cA, voffA); PG8_STAGE(PG8_SB(0, 1), cB + hstep, voffB); PG8_STAGE(PG8_SA(0, 1), cA + hstep, voffA);
        if (wr == 1) PG8_BAR;
        PG8_WAIT_V(4); PG8_BAR;
        PG8_STAGE(PG8_SB(1, 0), cB + kstep, voffB); PG8_STAGE(PG8_SA(1, 0), cA + kstep, voffA); PG8_STAGE(PG8_SB(1, 1), cB + hstep + kstep, voffB);
        PG8_WAIT_V(6); PG8_BAR;
    }
    for (;;) {
        const bool has_next = S.next(ui + 1, nxt);
        const char* nA = has_next ? (const char*)g.A + (size_t)nxt.pm * tstep : cA; const char* nB = has_next ? (const char*)g.Bt + (size_t)nxt.pn * tstep : cB;
        for (int t = 0; t < nt; t += 2) {
            const bool last = (t == nt - 2);
            const char* a1 = cA + (size_t)(t + 1) * kstep;
            const char* a2 = last ? nA : cA + (size_t)(t + 2) * kstep; const char* b2 = last ? nB : cB + (size_t)(t + 2) * kstep;
            const char* a3 = a2 + kstep; const char* b3 = b2 + kstep;
            if (last && has_next) S.a_ready(nxt);
            if constexpr (SP2) {
            PG8_LDB(B0, 0, 0); PG8_LDB(B1, 0, 1); PG8_SCHED; PG8_LDA(At, 0, 0); PG8_STAGE(PG8_SA(1, 1), a1 + hstep, voffA);
            PG8_WAIT_V(8); PG8_WAIT_L(0); PG8_BAR; PG8_MMA(0, 0, At, B0); PG8_MMA(0, 1, At, B1); PG8_BAR; PG8_SCHED;
            PG8_LDA(At, 0, 1); PG8_STAGE(PG8_SB(0, 0), b2, voffB); PG8_STAGE(PG8_SB(0, 1), b2 + hstep, voffB); PG8_STAGE(PG8_SA(0, 0), a2, voffA);
            PG8_WAIT_V(8); PG8_WAIT_L(0); PG8_BAR; PG8_MMA(1, 0, At, B0); PG8_MMA(1, 1, At, B1); PG8_BAR; PG8_SCHED;
            PG8_LDB(B0, 1, 0); PG8_LDB(B1, 1, 1); PG8_SCHED; PG8_LDA(At, 1, 0); PG8_STAGE(PG8_SA(0, 1), a2 + hstep, voffA);
            PG8_WAIT_V(8); PG8_WAIT_L(0); PG8_BAR; PG8_MMA(0, 0, At, B0); PG8_MMA(0, 1, At, B1); PG8_BAR; PG8_SCHED;
            PG8_LDA(At, 1, 1); PG8_STAGE(PG8_SB(1, 0), b3, voffB); PG8_STAGE(PG8_SB(1, 1), b3 + hstep, voffB); PG8_STAGE(PG8_SA(1, 0), a3, voffA);
            PG8_WAIT_V(8); PG8_WAIT_L(0); PG8_BAR; PG8_MMA(1, 0, At, B0); PG8_MMA(1, 1, At, B1); PG8_BAR; PG8_SCHED;
            } else {
            PG8_LDB(B0, 0, 0); PG8_SCHED; PG8_LDA(At, 0, 0); PG8_STAGE(PG8_SA(1, 1), a1 + hstep, voffA);
            PG8_WAIT_L(8); PG8_BAR; PG8_WAIT_L(0); PG8_MMA(0, 0, At, B0); PG8_BAR; PG8_SCHED;
            PG8_LDB(B1, 0, 1); PG8_STAGE(PG8_SB(0, 0), b2, voffB);
            PG8_BAR; PG8_WAIT_L(0); PG8_MMA(0, 1, At, B1); PG8_BAR;
            PG8_LDA(At, 0, 1); PG8_STAGE(PG8_SA(0, 0), a2, voffA);
            PG8_BAR; PG8_WAIT_L(0); PG8_MMA(1, 0, At, B0); PG8_BAR; PG8_SCHED;
            PG8_STAGE(PG8_SB(0, 1), b2 + hstep, voffB);
            PG8_WAIT_V(6); PG8_BAR; PG8_MMA(1, 1, At, B1); PG8_BAR;
            PG8_LDB(B0, 1, 0); PG8_SCHED; PG8_LDA(At, 1, 0); PG8_STAGE(PG8_SA(0, 1), a2 + hstep, voffA);
            PG8_WAIT_L(8); PG8_BAR; PG8_WAIT_L(0); PG8_MMA(0, 0, At, B0); PG8_BAR; PG8_SCHED;
            PG8_LDB(B1, 1, 1); PG8_STAGE(PG8_SB(1, 0), b3, voffB);
            PG8_BAR; PG8_WAIT_L(0); PG8_MMA(0, 1, At, B1); PG8_BAR;
            PG8_LDA(At, 1, 1); PG8_STAGE(PG8_SA(1, 0), a3, voffA);
            PG8_BAR; PG8_WAIT_L(0); PG8_MMA(1, 0, At, B0); PG8_BAR; PG8_SCHED;
            PG8_STAGE(PG8_SB(1, 1), b3 + hstep, voffB);
            PG8_WAIT_V(6); PG8_BAR; PG8_MMA(1, 1, At, B1); PG8_BAR;
            }
        }
        if constexpr (ALIGN_EPI) { if (wr == 0) PG8_BAR; }
        if constexpr (!Epi::AFTER_DRAIN) { E(acc, cur, wr, wc, fr, fq); S.done(cur); }
        if (!has_next) break;
#pragma unroll
        for (int a = 0; a < 2; ++a)
#pragma unroll
            for (int b = 0; b < 2; ++b)
#pragma unroll
                for (int m = 0; m < 4; ++m)
#pragma unroll
                    for (int n = 0; n < 2; ++n) acc[a][b][m][n] = (f32x4){0.f, 0.f, 0.f, 0.f};
        cur = nxt; cA = nA; cB = nB; ++ui;
        if constexpr (ALIGN_EPI) { if (wr == 1) PG8_BAR; }
    }
    PG8_WAIT_V(0);
    if constexpr (!ALIGN_EPI) { if (wr == 0) PG8_BAR; }
    PG8_BAR;
    if constexpr (Epi::AFTER_DRAIN) { E.fused(acc, cur, wr, wc, fr, fq, lds, wid, lane); S.done(cur); }
#undef PG8_SA
#undef PG8_SB
#undef PG8_STAGE
#undef PG8_LDA
#undef PG8_LDB
#undef PG8_MMA
#undef PG8_WAIT_V
#undef PG8_WAIT_L
#undef PG8_BAR
#undef PG8_SCHED
}
}
#ifndef PG8_SP2
#define PG8_SP2 true
#endif
#ifndef PG8_ALIGN
#define PG8_ALIGN true
#endif
namespace att {
typedef unsigned short bf16;
using bf16x8 = __attribute__((ext_vector_type(8))) short;
using s16x4  = __attribute__((ext_vector_type(4))) short;
using f32x16 = __attribute__((ext_vector_type(16))) float;
using u32x4  = __attribute__((ext_vector_type(4))) unsigned;
constexpr int KVBLK = 64, LDP = DIN;
constexpr float LOG2E = 1.4426950408889634f;
constexpr float QSCALE = 0.125f * LOG2E;
constexpr float THR2 = 8.f * LOG2E;
constexpr int NSLOT = 2, SLOTB = 16384;
constexpr int L_TAB = 0, L_WS = 8192, L_K = 10240, L_V = L_K + NSLOT * SLOTB, L_END = L_V + NSLOT * SLOTB;
__device__ __forceinline__ int crow(int r, int hi) { return (r & 3) + 8 * (r >> 2) + 4 * hi; }
__device__ __forceinline__ float bf2f(bf16 v) { return __uint_as_float((unsigned)v << 16); }
__device__ __forceinline__ bf16 f2bf(float f) { unsigned u = __float_as_uint(f); return (bf16)((u + 0x7fffu + ((u >> 16) & 1u)) >> 16); }
template <int KW> __device__ __forceinline__ int kswz(int row, int colB) { return row * (KW * 2) + (colB ^ ((row & (KW == 128 ? 15 : 7)) << 4)); }
template <int NCB> __device__ __forceinline__ int v_st(int k, int c) { const int kk = (k & ~0xC) | ((k & 4) << 1) | ((k & 8) >> 1); return ((kk >> 3) * NCB + (c >> 5)) * 512 + ((kk & 7) * 32 + (c & 31)) * 2; }
__device__ __forceinline__ int v_rd_base(int lane) { return ((lane & 3) << 3) | (((lane >> 2) & 3) << 6) | (((lane >> 4) & 1) << 5) | (((lane >> 5) & 1) << 8); }
template <int NCB> constexpr int v_rd_off(int d0, int ks, int half) { return ((2 * ks + half) * NCB + d0) * 512; }
typedef __attribute__((address_space(3))) const char* lds_cptr;
typedef __attribute__((address_space(3))) char* lds_ptr;
typedef __attribute__((address_space(3))) float* lds_fptr;
typedef short v4i16_t __attribute__((ext_vector_type(4)));
__device__ __forceinline__ s16x4 vtr(lds_cptr p) { return __builtin_bit_cast(s16x4, __builtin_amdgcn_ds_read_tr16_b64_v4i16((__attribute__((address_space(3))) v4i16_t*)p)); }
typedef float f32x2_t __attribute__((ext_vector_type(2))); typedef __bf16 bf16x2_t __attribute__((ext_vector_type(2)));
__device__ __forceinline__ unsigned cvtpk_s(float lo, float hi) { f32x2_t v = {lo, hi}; bf16x2_t b = __builtin_convertvector(v, bf16x2_t); return __builtin_bit_cast(unsigned, b); }
#define PK4(P, BASE, OUT) do { unsigned a0 = cvtpk_s(P[BASE + 0], P[BASE + 1]), a1 = cvtpk_s(P[BASE + 2], P[BASE + 3]);   \
    unsigned b0 = cvtpk_s(P[BASE + 4], P[BASE + 5]), b1 = cvtpk_s(P[BASE + 6], P[BASE + 7]);                              \
    auto r0 = __builtin_amdgcn_permlane32_swap(a0, b0, false, false); auto r1 = __builtin_amdgcn_permlane32_swap(a1, b1, false, false); \
    u32x4 w = {r0[0], r1[0], r0[1], r1[1]}; OUT = *reinterpret_cast<bf16x8*>(&w); } while (0)
__device__ __forceinline__ float max3f(float a, float b, float c) { float r; asm("v_max3_f32 %0, %1, %2, %3" : "=v"(r) : "v"(a), "v"(b), "v"(c)); return r; }
__device__ __forceinline__ float max2f(float a, float b) { float r; asm("v_max_f32_e32 %0, %1, %2" : "=v"(r) : "v"(a), "v"(b)); return r; }
struct Consts { const float* rel_bias; const float* sink; const float* lq1; const float* lk1; const float* lq2; const float* lk2; const float* subw; };

template <int MODE>
__device__ __forceinline__ void attn_unit(const bf16* __restrict__ P, bf16* __restrict__ CC, const Consts& cs, long rowbase, int q0, int kt0, int NT, int hd, lds_ptr lds) {
  constexpr int DV = MODE == 0 ? 128 : 64, KW = MODE == 0 ? 128 : 64, NCB = DV / 32, NLD = MODE == 0 ? 2 : 1;
  const int tid = fresh_tid(), lane = tid & 63, r32 = lane & 31, hi = lane >> 5;
  const int wid = __builtin_amdgcn_readfirstlane(tid >> 6), msel = wid >> 2, rg = wid & 3;
  const lds_ptr K_lds = lds + L_K; const lds_ptr V_lds = lds + L_V;
  const lds_fptr wsf = (lds_fptr)(lds + L_WS) + wid * 64; const lds_fptr li_l = wsf; const lds_fptr al_l = wsf + 32;
  const lds_fptr tabw = (lds_fptr)(lds + L_TAB);
  int qcol, kcol, vcol, gcol, ocol, kq, bcol;
  if constexpr (MODE == 0) { qcol = 1280 + hd * 128 + msel * 64; kcol = 1792 + hd * 128; vcol = 2304 + hd * 128; gcol = 2816 + hd * 128; ocol = 512 + hd * 128; kq = msel * 64; bcol = 8 + hd; }
  else { const int kvh = hd >> 1, qh = kvh * 4 + (hd & 1) * 2 + msel; qcol = qh * 64; kcol = 512 + kvh * 64; vcol = 640 + kvh * 64; gcol = 768 + qh * 64; ocol = qh * 64; kq = 0; bcol = qh; }
  if constexpr (MODE == 0) {
    for (int i = tid; i < 1024; i += 512) tabw[i] = LOG2E * cs.rel_bias[t5_bucket(i - 512) * 12 + 8 + hd];
  } else {
    const int qh0 = (hd >> 1) * 4 + (hd & 1) * 2;
    for (int i = tid; i < 2048; i += 512) { const int rel = (i & 1023) - 512; const int a = rel < 0 ? -rel : rel;
      tabw[i] = a <= 128 ? LOG2E * cs.rel_bias[t5_bucket(rel) * 12 + qh0 + (i >> 10)] : -1e30f; }
  }
  const __attribute__((address_space(3))) float* tab = tabw + (MODE == 1 ? msel * 1024 : 0);
  float cLo = 0.f, cHi = 0.f;
  if constexpr (MODE == 0) { cLo = __uint_as_float(__builtin_amdgcn_readfirstlane(__float_as_uint(LOG2E * cs.rel_bias[15 * 12 + bcol])));
                             cHi = __uint_as_float(__builtin_amdgcn_readfirstlane(__float_as_uint(LOG2E * cs.rel_bias[31 * 12 + bcol]))); }
  float mhat = 0.f, l_reg = 0.f;
  if constexpr (MODE == 1) { mhat = LOG2E * cs.sink[bcol]; l_reg = 1.f; }
  f32x16 o[NCB];
#pragma unroll
  for (int d = 0; d < NCB; ++d) o[d] = f32x16{};
  bf16x8 qr[4];
  const int qw = q0 + rg * 32;
  const bf16* Qw = P + (size_t)(rowbase + qw + r32) * LDP + qcol + hi * 8;
#pragma unroll
  for (int d0 = 0; d0 < 4; ++d0) qr[d0] = *reinterpret_cast<const bf16x8*>(Qw + d0 * 16);
  const int sr = MODE == 0 ? (tid >> 4) : (tid >> 3), sc = MODE == 0 ? (tid & 15) * 8 : (tid & 7) * 8;
  const int kbase = kt0 * KVBLK;
  const bf16* Kg = P + (size_t)(rowbase + kbase + sr) * LDP + kcol + sc;
  const bf16* Vg = P + (size_t)(rowbase + kbase + sr) * LDP + vcol + sc;
  typedef __attribute__((address_space(3))) bf16x8* lds_b8; typedef const __attribute__((address_space(3))) bf16x8* lds_cb8;
  const lds_ptr kst0 = K_lds + kswz<KW>(sr, sc * 2), kst1 = K_lds + kswz<KW>(32 + sr, sc * 2), vst0 = V_lds + v_st<NCB>(sr, sc), vst1 = V_lds + v_st<NCB>(32 + sr, sc);
  const lds_cptr vp0 = (lds_cptr)V_lds + v_rd_base(lane);
  bf16x8 ks0, ks1, vs0, vs1;
#define KLOAD(t) do { const size_t o_ = (size_t)(t) * KVBLK * LDP; ks0 = *reinterpret_cast<const bf16x8*>(Kg + o_); if constexpr (NLD == 2) ks1 = *reinterpret_cast<const bf16x8*>(Kg + o_ + 32 * LDP); } while (0)
#define VLOAD(t) do { const size_t o_ = (size_t)(t) * KVBLK * LDP; vs0 = *reinterpret_cast<const bf16x8*>(Vg + o_); if constexpr (NLD == 2) vs1 = *reinterpret_cast<const bf16x8*>(Vg + o_ + 32 * LDP); } while (0)
#define KWRITE(sl) do { *(lds_b8)(kst0 + (sl)) = ks0; if constexpr (NLD == 2) *(lds_b8)(kst1 + (sl)) = ks1; } while (0)
#define VWRITE(sl) do { *(lds_b8)(vst0 + (sl)) = vs0; if constexpr (NLD == 2) *(lds_b8)(vst1 + (sl)) = vs1; } while (0)
#define BAR() __syncthreads()
  f32x16 negm; float cb_cur = 0.f; bool dirty = true;
#define NEGM(t) do { float cbt_ = 0.f; if constexpr (MODE == 0) { const int k0_ = kbase + (t) * KVBLK; cbt_ = (k0_ > qw - 154 && k0_ < qw + 122) ? 0.f : (k0_ < qw ? cLo : cHi); } \
    if (dirty || cbt_ != cb_cur) { cb_cur = cbt_; dirty = false; _Pragma("unroll") for (int r = 0; r < 16; ++r) negm[r] = cbt_ - mhat; asm volatile("" : "+v"(negm)); } } while (0)
#define QKT(P0, P1, sl) do { _Pragma("unroll") for (int d0 = 0; d0 < 4; ++d0) { const int cbb_ = (kq + d0 * 16 + hi * 8) * 2; \
      const bf16x8 b0_ = *(lds_cb8)((lds_cptr)K_lds + (sl) + kswz<KW>(r32, cbb_)), b1_ = *(lds_cb8)((lds_cptr)K_lds + (sl) + kswz<KW>(32 + r32, cbb_)); \
      if (d0 == 0) { P0 = __builtin_amdgcn_mfma_f32_32x32x16_bf16(b0_, qr[0], negm, 0, 0, 0); P1 = __builtin_amdgcn_mfma_f32_32x32x16_bf16(b1_, qr[0], negm, 0, 0, 0); } \
      else { P0 = __builtin_amdgcn_mfma_f32_32x32x16_bf16(b0_, qr[d0], P0, 0, 0, 0); P1 = __builtin_amdgcn_mfma_f32_32x32x16_bf16(b1_, qr[d0], P1, 0, 0, 0); } } } while (0)
#define PSM(P0, P1, t, AL) do { \
    asm volatile("s_nop 15\n\ts_nop 7" : "+v"(P0), "+v"(P1));     \
    { const int k0_ = kbase + (t) * KVBLK; if (MODE == 1 || (k0_ > qw - 154 && k0_ < qw + 122)) { const int base_ = k0_ - qw - r32 + 4 * hi + 512; \
        _Pragma("unroll") for (int r = 0; r < 16; ++r) { const int o_ = (r & 3) + 8 * (r >> 2); P0[r] += tab[base_ + o_]; P1[r] += tab[base_ + o_ + 32]; } } } \
    float a_ = max3f(P0[0], P0[1], P1[0]), b_ = max3f(P0[2], P0[3], P1[1]); a_ = max3f(a_, P1[2], P1[3]); \
    _Pragma("unroll") for (int r = 4; r < 16; r += 4) { a_ = max3f(a_, P0[r], P0[r + 1]); b_ = max3f(b_, P0[r + 2], P0[r + 3]); a_ = max3f(a_, P1[r], P1[r + 1]); b_ = max3f(b_, P1[r + 2], P1[r + 3]); } \
    float pm_ = max2f(a_, b_); { auto rr = __builtin_amdgcn_permlane32_swap(__float_as_uint(pm_), __float_as_uint(pm_), false, false); pm_ = max2f(__uint_as_float(rr[0]), __uint_as_float(rr[1])); } \
    AL = 1.f; \
    if (__builtin_expect(__any(pm_ > THR2), 0)) { const float dl_ = fmaxf(pm_, 0.f); mhat += dl_; \
      _Pragma("unroll") for (int r = 0; r < 16; ++r) { P0[r] -= dl_; P1[r] -= dl_; } \
      AL = __builtin_amdgcn_exp2f(-dl_); dirty = true; } \
    _Pragma("unroll") for (int r = 0; r < 16; ++r) P0[r] = __builtin_amdgcn_exp2f(P0[r]); } while (0)
#define FSM(P0, P1, AL) do { \
    _Pragma("unroll") for (int r = 0; r < 16; ++r) P1[r] = __builtin_amdgcn_exp2f(P1[r]); \
    float ps0_ = P0[0] + P1[0], ps1_ = P0[1] + P1[1], ps2_ = P0[2] + P1[2], ps3_ = P0[3] + P1[3]; \
    _Pragma("unroll") for (int r = 4; r < 16; r += 4) { ps0_ += P0[r] + P1[r]; ps1_ += P0[r + 1] + P1[r + 1]; ps2_ += P0[r + 2] + P1[r + 2]; ps3_ += P0[r + 3] + P1[r + 3]; } \
    float ps_ = (ps0_ + ps1_) + (ps2_ + ps3_); \
    { auto rr = __builtin_amdgcn_permlane32_swap(__float_as_uint(ps_), __float_as_uint(ps_), false, false); ps_ = __uint_as_float(rr[0]) + __uint_as_float(rr[1]); } \
    l_reg = l_reg * AL + ps_; \
    PK4(P0, 0, pa0); PK4(P0, 8, pa1); PK4(P1, 0, pa2); PK4(P1, 8, pa3); } while (0)
#define RESC(a) do { if (__any((a) < 1.f)) { if (hi == 0) al_l[r32] = (a); asm volatile("s_waitcnt lgkmcnt(0)" ::: "memory"); \
    _Pragma("unroll") for (int d = 0; d < NCB; ++d) _Pragma("unroll") for (int r = 0; r < 16; ++r) o[d][r] *= al_l[crow(r, hi)]; } } while (0)
#define PVB(D, sl) do { const lds_cptr vp_ = vp0 + (sl); \
    const s16x4 l0 = vtr(vp_ + v_rd_off<NCB>(D, 0, 0)), h0 = vtr(vp_ + v_rd_off<NCB>(D, 0, 1)), l1 = vtr(vp_ + v_rd_off<NCB>(D, 1, 0)), h1 = vtr(vp_ + v_rd_off<NCB>(D, 1, 1)); \
    const s16x4 l2 = vtr(vp_ + v_rd_off<NCB>(D, 2, 0)), h2 = vtr(vp_ + v_rd_off<NCB>(D, 2, 1)), l3 = vtr(vp_ + v_rd_off<NCB>(D, 3, 0)), h3 = vtr(vp_ + v_rd_off<NCB>(D, 3, 1)); \
    o[D] = __builtin_amdgcn_mfma_f32_32x32x16_bf16(pa0, (bf16x8){l0[0], l0[1], l0[2], l0[3], h0[0], h0[1], h0[2], h0[3]}, o[D], 0, 0, 0); \
    o[D] = __builtin_amdgcn_mfma_f32_32x32x16_bf16(pa1, (bf16x8){l1[0], l1[1], l1[2], l1[3], h1[0], h1[1], h1[2], h1[3]}, o[D], 0, 0, 0); \
    o[D] = __builtin_amdgcn_mfma_f32_32x32x16_bf16(pa2, (bf16x8){l2[0], l2[1], l2[2], l2[3], h2[0], h2[1], h2[2], h2[3]}, o[D], 0, 0, 0); \
    o[D] = __builtin_amdgcn_mfma_f32_32x32x16_bf16(pa3, (bf16x8){l3[0], l3[1], l3[2], l3[3], h3[0], h3[1], h3[2], h3[3]}, o[D], 0, 0, 0); } while (0)
#define PV(sl) do { PVB(0, sl); __builtin_amdgcn_sched_barrier(0); PVB(1, sl); __builtin_amdgcn_sched_barrier(0); if constexpr (NCB == 4) { PVB(2, sl); __builtin_amdgcn_sched_barrier(0); PVB(3, sl); } } while (0)
  f32x16 pA0, pA1, pB0, pB1; float alA, alB; bf16x8 pa0, pa1, pa2, pa3;
  KLOAD(0); VLOAD(0); KWRITE(0); KLOAD(1);
  BAR();
  NEGM(0); QKT(pA0, pA1, 0); KWRITE(SLOTB); KLOAD(2);
  PSM(pA0, pA1, 0, alA); VWRITE(0); VLOAD(1); BAR();
  for (int j = 1; j + 1 < NT; j += 2) {
    NEGM(j); QKT(pB0, pB1, SLOTB); FSM(pA0, pA1, alA); KWRITE(0); KLOAD(j + 2);
    PV(0); PSM(pB0, pB1, j, alB); RESC(alB); VWRITE(SLOTB); VLOAD(j + 1); BAR();
    NEGM(j + 1); QKT(pA0, pA1, 0); FSM(pB0, pB1, alB); KWRITE(SLOTB); if (j + 3 < NT) KLOAD(j + 3);
    PV(SLOTB); PSM(pA0, pA1, j + 1, alA); RESC(alA); VWRITE(0); VLOAD(j + 2); BAR();
  }
  NEGM(NT - 1); QKT(pB0, pB1, SLOTB); FSM(pA0, pA1, alA);
  PV(0); PSM(pB0, pB1, NT - 1, alB); RESC(alB); VWRITE(SLOTB); BAR();
  FSM(pB0, pB1, alB);
  PV(SLOTB);
  if (hi == 0) li_l[r32] = l_reg; asm volatile("s_waitcnt lgkmcnt(0)" ::: "memory");
  float rli[16];
#pragma unroll
  for (int r = 0; r < 16; ++r) rli[r] = __builtin_amdgcn_rcpf(li_l[crow(r, hi)]);
  const size_t trow = (size_t)(rowbase + qw);
  if constexpr (MODE == 1) {
#pragma unroll
    for (int r = 0; r < 16; ++r) { const size_t row = trow + crow(r, hi);
#pragma unroll
      for (int d0 = 0; d0 < NCB; ++d0) { const int col = d0 * 32 + r32; const float g = bf2f(P[row * LDP + gcol + col]); CC[row * DM + ocol + col] = f2bf(o[d0][r] * rli[r] * g); } }
    BAR();
  } else {
    const lds_fptr X = (lds_fptr)(lds + L_K);
    BAR();
    if (msel == 1) {
#pragma unroll
      for (int r = 0; r < 16; ++r)
#pragma unroll
        for (int d0 = 0; d0 < NCB; ++d0) X[(rg * 32 + crow(r, hi)) * 128 + d0 * 32 + r32] = o[d0][r] * rli[r];
    }
    float s1 = cs.lq1[lane] * cs.lk1[lane], s2 = cs.lq2[lane] * cs.lk2[lane];
#pragma unroll
    for (int of = 1; of < 64; of <<= 1) { s1 += __shfl_xor(s1, of); s2 += __shfl_xor(s2, of); }
    const float lam = __expf(s1) - __expf(s2) + LAMBDA_INIT;
    BAR();
    if (msel == 0) {
      float rn[16];
#pragma unroll
      for (int r = 0; r < 16; ++r) { float ss = 0.f;
#pragma unroll
        for (int d0 = 0; d0 < NCB; ++d0) { const float d = o[d0][r] * rli[r] - lam * X[(rg * 32 + crow(r, hi)) * 128 + d0 * 32 + r32]; o[d0][r] = d; ss += d * d; }
        ss += __shfl_xor(ss, 1); ss += __shfl_xor(ss, 2); ss += __shfl_xor(ss, 4); ss += __shfl_xor(ss, 8); ss += __shfl_xor(ss, 16);
        rn[r] = __builtin_amdgcn_rsqf(ss * (1.f / 128.f) + SUBLN_EPS) * (1.f - LAMBDA_INIT); }
      float sw[NCB];
#pragma unroll
      for (int d0 = 0; d0 < NCB; ++d0) sw[d0] = cs.subw[d0 * 32 + r32];
#pragma unroll
      for (int r = 0; r < 16; ++r) { const size_t row = trow + crow(r, hi);
#pragma unroll
        for (int d0 = 0; d0 < NCB; ++d0) { const int col = d0 * 32 + r32; const float g = bf2f(P[row * LDP + gcol + col]); CC[row * DM + ocol + col] = f2bf(o[d0][r] * rn[r] * sw[d0] * g); } }
    }
    BAR();
  }
#undef KLOAD
#undef VLOAD
#undef KWRITE
#undef VWRITE
#undef BAR
#undef NEGM
#undef QKT
#undef PSM
#undef FSM
#undef RESC
#undef PVB
#undef PV
}
#undef PK4
}

constexpr int NWAVES = 8;
constexpr size_t MiB = 1u << 20;
constexpr size_t WS_CTL = 0, CTL_ZERO_BYTES = 1 * MiB;
constexpr size_t WS_WIN = 2 * MiB;
constexpr size_t WS_WOUT = 9 * MiB;
constexpr size_t WS_MOD = 11 * MiB;
constexpr size_t WS_U = 16 * MiB;
constexpr size_t WS_PROJ = 112 * MiB;
constexpr size_t WS_END = 424 * MiB;
constexpr int CW_TMO = 0, CW_CODE = 1, CW_BAR = 4096;
constexpr int RING_OFF = 0, RING_BYTES = 131072;
constexpr int LDSCTL_OFF = RING_BYTES, MISC_OFF = LDSCTL_OFF + 320;
constexpr int LDS_BYTES = 147456;
static_assert(att::L_END <= RING_BYTES, "attention scratch inside the ring");

#define GAS __attribute__((address_space(1)))
#define LAS __attribute__((address_space(3)))
typedef unsigned short bf16;
typedef unsigned v4u __attribute__((ext_vector_type(4)));
typedef float f32x4 __attribute__((ext_vector_type(4)));
typedef GAS unsigned gu32;
#define RLX_AGENT __ATOMIC_RELAXED, __HIP_MEMORY_SCOPE_AGENT
#define LDS_WAIT() asm volatile("s_waitcnt lgkmcnt(0)" ::: "memory")
#define VM_WAIT() asm volatile("s_waitcnt vmcnt(0)" ::: "memory")
__device__ __forceinline__ unsigned f2bf(float f) { unsigned u = __builtin_bit_cast(unsigned, f); return (u + 0x7fffu + ((u >> 16) & 1u)) >> 16; }
__device__ __forceinline__ unsigned pk2(float lo, float hi) { return f2bf(lo) | (f2bf(hi) << 16); }

#define XB_TMO      128
#define XB_XCNT(j)  (256  + 64 * (j))
#define XB_XSUB(j)  (1280 + 64 * (j))
#define XB_XGEN(j)  (2304 + 64 * (j))
#define XB_TOP      3328
#define XB_TOPGEN   3392
#define XCD_BAR_WORDS 3456
#define XB_SPIN_CAP (1u << 18)

__device__ __forceinline__ unsigned xb_ld(unsigned* p)              { return __hip_atomic_load(p, __ATOMIC_RELAXED, __HIP_MEMORY_SCOPE_AGENT); }
__device__ __forceinline__ unsigned xb_add(unsigned* p, unsigned v) { return __hip_atomic_fetch_add(p, v, __ATOMIC_RELAXED, __HIP_MEMORY_SCOPE_AGENT); }
__device__ __forceinline__ unsigned xb_xcc_id() { return (unsigned)__builtin_amdgcn_s_getreg((3 << 11) | 20) & 0xFu; }
#define XB_SPIN(cond, bar) do { unsigned _sp = 0; while (cond) { __builtin_amdgcn_s_sleep(1); \
    if ((++_sp & 255u) == 0u) { if (xb_ld(&(bar)[XB_TMO])) break; if (_sp > XB_SPIN_CAP) { atomicAdd(&(bar)[XB_TMO], 1u); break; } } } } while (0)

struct XcdBarrier {
    unsigned* bar; unsigned x;
    volatile LAS unsigned* st;
};

__device__ __forceinline__ XcdBarrier xcd_barrier_post(unsigned* bar, volatile LAS unsigned* st) {
    XcdBarrier b; b.bar = bar; b.x = xb_xcc_id(); b.st = st;
    if (threadIdx.x == 0) (void)xb_add(&bar[XB_XCNT(b.x)], 1u);
    return b;
}
__device__ __forceinline__ void xcd_barrier_complete(unsigned* bar, unsigned x, unsigned& nloc, unsigned& nx) {
    const unsigned G = gridDim.x * gridDim.y * gridDim.z;
    unsigned sum, cnt, mine, sp = 0u;
    for (;;) {
        sum = 0u; cnt = 0u; mine = 0u;
#pragma unroll
        for (unsigned j = 0; j < 16; ++j) { const unsigned c = xb_ld(&bar[XB_XCNT(j)]); sum += c; cnt += (c > 0u) ? 1u : 0u; mine = (j == x) ? c : mine; }
        if (sum == G) break;
        __builtin_amdgcn_s_sleep(1);
        if ((++sp & 255u) == 0u) { if (xb_ld(&bar[XB_TMO])) break; if (sp > XB_SPIN_CAP) { atomicAdd(&bar[XB_TMO], 1u); break; } }
    }
    nloc = mine > 0u ? mine : 1u; nx = cnt > 0u ? cnt : 1u;
}

__device__ __forceinline__ void xcd_barrier(const XcdBarrier& b) {
    asm volatile("s_waitcnt vmcnt(0)" ::: "memory");
    __syncthreads();
    if (threadIdx.x == 0) {
        unsigned* bar = b.bar;
        __builtin_amdgcn_s_waitcnt(0);
        unsigned nloc = b.st[0], nx = b.st[1];
        if (nloc == 0u) { xcd_barrier_complete(bar, b.x, nloc, nx); b.st[0] = nloc; b.st[1] = nx; }
        const unsigned old = xb_add(&bar[XB_XSUB(b.x)], 1u);
        const unsigned gen = old / nloc;
        if (old + 1u == (gen + 1u) * nloc) {
            __builtin_amdgcn_fence(__ATOMIC_RELEASE, "agent");
            asm volatile("s_waitcnt vmcnt(0)" ::: "memory");
            const unsigned og = xb_add(&bar[XB_TOP], 1u);
            const unsigned tg = og / nx;
            if (og + 1u == (tg + 1u) * nx) xb_add(&bar[XB_TOPGEN], 1u);
            else XB_SPIN(xb_ld(&bar[XB_TOPGEN]) == tg, bar);
            __builtin_amdgcn_fence(__ATOMIC_ACQUIRE, "agent");
            xb_add(&bar[XB_XGEN(b.x)], 1u);
            asm volatile("s_waitcnt vmcnt(0)" ::: "memory");
        } else {
            XB_SPIN(xb_ld(&bar[XB_XGEN(b.x)]) == gen, bar);
            __builtin_amdgcn_fence(__ATOMIC_ACQUIRE, "agent");
            asm volatile("s_waitcnt vmcnt(0)" ::: "memory");
        }
    }
    __syncthreads();
}
struct Frame {
    LAS unsigned char* lds;
    volatile LAS unsigned* MISC;
    gu32* ctl;
    int tid, lane, wave;
    int vcu, G;
    const float *xp, *xs, *cp, *cs, *w_in, *w_out, *w_ada, *b_ada, *ln_g, *ln_b;
    float* out;
    bf16 *Win_t, *Wout_t, *U, *PROJ;
    float* MOD;
};
__device__ __forceinline__ float wave_sum(float v) {
#pragma unroll
    for (int o = 1; o < 64; o <<= 1) v += __shfl_xor(v, o);
    return v;
}
__device__ __forceinline__ void p0_transpose_item(const float* W, int K, int N, bf16* WT, int row_off, LAS float* scr, int item, int lane) {
    const int nblk = N / 32, kb = item / nblk, nb = item % nblk, k0 = 64 * kb, n0 = 32 * nb;
#pragma unroll 8
    for (int i = 0; i < 32; ++i) { const int kk = 2 * i + (lane >> 5); scr[kk * 33 + (lane & 31)] = W[(size_t)(k0 + kk) * N + n0 + (lane & 31)]; }
    LDS_WAIT(); asm volatile("" ::: "memory");
    const int c = lane & 7;
#pragma unroll
    for (int j = 0; j < 4; ++j) { const int n = (lane >> 3) + 8 * j; const LAS float* s = scr + (8 * c) * 33 + n;
        v4u o; o.x = pk2(s[0 * 33], s[1 * 33]); o.y = pk2(s[2 * 33], s[3 * 33]); o.z = pk2(s[4 * 33], s[5 * 33]); o.w = pk2(s[6 * 33], s[7 * 33]);
        *(GAS v4u*)(WT + (size_t)(row_off + n0 + n) * K + k0 + 8 * c) = o; }
    LDS_WAIT(); asm volatile("" ::: "memory");
}
__device__ __forceinline__ void p0_prologue(Frame& F0) {
    Frame F = F0; F.tid = fresh_tid(); F.lane = F.tid & 63;
    LAS float* scr = (LAS float*)(F.lds + RING_OFF + F.wave * 16384);
    const int gw = F.vcu * NWAVES + F.wave, NGW = F.G * NWAVES;
    constexpr int I_IN = (DM / 64) * (DIN / 32), I_OUT = (DM / 64) * (DM / 32);
    for (int it = gw; it < I_IN + I_OUT; it += NGW) {
        if (it < I_IN) p0_transpose_item(F.w_in, DM, DIN, F.Win_t, 0, scr, it, F.lane);
        else p0_transpose_item(F.w_out, DM, DM, F.Wout_t, 0, scr, it - I_IN, F.lane);
    }
    __syncthreads();
    constexpr int NITEM = 3072 / 16;
    if (F.vcu * NWAVES < NITEM) {
        LAS float* sc = (LAS float*)(F.lds + RING_OFF);
        for (int i = F.tid; i < 12 * 1024; i += NWAVES * 64) { const int k = i / 12, b = i - k * 12; float v = 0.f;
            if (b < 8) v = silu_f(F.cp[b * 1024 + k]); else if (b < 10) v = silu_f(F.cs[(b - 8) * 1024 + k]);
            sc[i] = v; }
        __syncthreads();
        for (int it = gw; it < NITEM; it += NGW) {
            const int n0 = it * 16, col = F.lane & 15, kg = F.lane >> 4;
            float acc[12];
#pragma unroll
            for (int b = 0; b < 12; ++b) acc[b] = 0.f;
#pragma unroll 32
            for (int i = 0; i < 256; ++i) { const int k = 4 * i + kg; const float w = F.w_ada[(size_t)k * 3072 + n0 + col];
                const f32x4 s0 = *(const LAS f32x4*)(sc + k * 12), s1 = *(const LAS f32x4*)(sc + k * 12 + 4), s2 = *(const LAS f32x4*)(sc + k * 12 + 8);
                acc[0] += s0[0] * w; acc[1] += s0[1] * w; acc[2] += s0[2] * w; acc[3] += s0[3] * w; acc[4] += s1[0] * w; acc[5] += s1[1] * w;
                acc[6] += s1[2] * w; acc[7] += s1[3] * w; acc[8] += s2[0] * w; acc[9] += s2[1] * w; }
#pragma unroll
            for (int b = 0; b < 10; ++b) { acc[b] += __shfl_xor(acc[b], 16); acc[b] += __shfl_xor(acc[b], 32); }
            if (F.lane < 16) { const int n = n0 + F.lane; const float add = F.b_ada[n] + ((n >= 1024 && n < 2048) ? 1.f : 0.f);
#pragma unroll
                for (int b = 0; b < 10; ++b) F.MOD[b * 3072 + n] = acc[b] + add; }
        }
    }
}
__device__ __forceinline__ void p1_modulate(Frame& F0) {
    Frame F = F0; F.tid = fresh_tid(); F.lane = F.tid & 63;
    constexpr int RPW = 4;
    const int gw = F.vcu * NWAVES + F.wave, NGW = F.G * NWAVES;
    for (int m0 = gw * RPW; m0 < NTOK; m0 += NGW * RPW) {
        const int b = tok_batch(m0);
        const float* xrow = m0 < NPROMPT ? F.xp + (size_t)m0 * DM : F.xs + (size_t)(m0 - NPROMPT) * DM;
        const GAS f32x4* xr = (const GAS f32x4*)xrow + F.lane;
        const GAS f32x4* sh = (const GAS f32x4*)(F.MOD + b * 3072) + F.lane; const GAS f32x4* scl = (const GAS f32x4*)(F.MOD + b * 3072 + 1024) + F.lane;
        GAS unsigned long long* o8 = (GAS unsigned long long*)(F.U + (size_t)m0 * DM) + F.lane;
        f32x4 xv[RPW][4];
#pragma unroll
        for (int r = 0; r < RPW; ++r)
#pragma unroll
            for (int j = 0; j < 4; ++j) xv[r][j] = xr[r * 256 + 64 * j];
#pragma unroll
        for (int j = 0; j < 4; ++j) { const f32x4 s4 = scl[64 * j], t4 = sh[64 * j];
#pragma unroll
            for (int r = 0; r < RPW; ++r) { const f32x4 v = xv[r][j] * s4 + t4;
                o8[r * 256 + 64 * j] = (unsigned long long)pk2(v.x, v.y) | ((unsigned long long)pk2(v.z, v.w) << 32); } }
    }
}
__device__ __forceinline__ void p5_layernorm(Frame& F0) {
    Frame F = F0; F.tid = fresh_tid(); F.lane = F.tid & 63;
    constexpr int RPW = 4;
    const int gw = F.vcu * NWAVES + F.wave, NGW = F.G * NWAVES;
    for (int m0 = gw * RPW; m0 < NTOK; m0 += NGW * RPW) {
        GAS f32x4* p = (GAS f32x4*)(F.out + (size_t)m0 * DM) + F.lane;
        f32x4 v[RPW][4]; float s[RPW], s2[RPW];
#pragma unroll
        for (int r = 0; r < RPW; ++r)
#pragma unroll
            for (int j = 0; j < 4; ++j) v[r][j] = p[r * 256 + 64 * j];
#pragma unroll
        for (int r = 0; r < RPW; ++r) { s[r] = 0.f;
#pragma unroll
            for (int j = 0; j < 4; ++j) s[r] += (v[r][j].x + v[r][j].y) + (v[r][j].z + v[r][j].w); }
#pragma unroll
        for (int o = 1; o < 64; o <<= 1)
#pragma unroll
            for (int r = 0; r < RPW; ++r) s[r] += __shfl_xor(s[r], o);
#pragma unroll
        for (int r = 0; r < RPW; ++r) { const float mean = s[r] * (1.f / DM); s2[r] = 0.f;
#pragma unroll
            for (int j = 0; j < 4; ++j) { v[r][j] = v[r][j] - mean; s2[r] += (v[r][j].x * v[r][j].x + v[r][j].y * v[r][j].y) + (v[r][j].z * v[r][j].z + v[r][j].w * v[r][j].w); } }
#pragma unroll
        for (int o = 1; o < 64; o <<= 1)
#pragma unroll
            for (int r = 0; r < RPW; ++r) s2[r] += __shfl_xor(s2[r], o);
#pragma unroll
        for (int j = 0; j < 4; ++j) { const f32x4 gg = ((const GAS f32x4*)F.ln_g)[F.lane + 64 * j], bb = ((const GAS f32x4*)F.ln_b)[F.lane + 64 * j];
#pragma unroll
            for (int r = 0; r < RPW; ++r) { const float rstd = 1.f / sqrtf(s2[r] * (1.f / DM) + LN_EPS); p[r * 256 + 64 * j] = v[r][j] * rstd * gg + bb; } }
    }
}

struct Args { const float* in[17]; float* out; unsigned char* ws; int ph_lo, ph_hi, li, pad; };
__global__ void __launch_bounds__(NWAVES * 64, 2) mega_fwd(Args args) {
    extern __shared__ __attribute__((aligned(16))) unsigned char lds[];
    Frame F;
    F.lds = (LAS unsigned char*)lds;
    F.MISC = (volatile LAS unsigned*)(F.lds + MISC_OFF);
    F.tid = threadIdx.x; F.lane = F.tid & 63; F.wave = __builtin_amdgcn_readfirstlane(F.tid >> 6);
    F.G = gridDim.x; { const int bx = blockIdx.x; F.vcu = (F.G % 8 == 0) ? (bx % 8) * (F.G / 8) + bx / 8 : bx; }
#define GRID_BAR(seam) do { if (N_LAUNCHES == PER_PHASE) { if (F.tid == 0) __hip_atomic_store(F.ctl + CW_TMO, 0xBADBA0u | (unsigned)(seam), RLX_AGENT); } \
    else { xcd_barrier(bar); } } while (0)
    unsigned char* ws = args.ws;
    F.ctl = (gu32*)(ws + WS_CTL);
    F.xp = args.in[0]; F.xs = args.in[1]; F.cp = args.in[2]; F.cs = args.in[3]; F.w_in = args.in[4]; F.w_out = args.in[5]; F.w_ada = args.in[6]; F.b_ada = args.in[7];
    F.ln_g = args.in[8]; F.ln_b = args.in[9]; F.out = args.out;
    F.Win_t = (bf16*)(ws + WS_WIN); F.Wout_t = (bf16*)(ws + WS_WOUT); F.U = (bf16*)(ws + WS_U); F.PROJ = (bf16*)(ws + WS_PROJ); F.MOD = (float*)(ws + WS_MOD);
    for (int u = F.tid; u < (LDS_BYTES - LDSCTL_OFF) / 4; u += NWAVES * 64) ((LAS unsigned*)(F.lds + LDSCTL_OFF))[u] = 0u;
    __syncthreads();
    XcdBarrier bar; bar.bar = (unsigned*)(F.ctl + CW_BAR); bar.x = 0; bar.st = nullptr;
    if (N_LAUNCHES != PER_PHASE) bar = xcd_barrier_post((unsigned*)(F.ctl + CW_BAR), F.MISC + 8);
    const int lo = args.ph_lo, hi = args.ph_hi;
#define IN(k) (lo <= (k) && (k) < hi)
#define BOTH(k) (IN(k) && IN((k) + 1))
    if (IN(0)) { p0_prologue(F); if (BOTH(0)) GRID_BAR(0); }
    if (IN(1)) { p1_modulate(F); if (BOTH(1)) GRID_BAR(1); }
    if (IN(2)) {
        pg8::Gemm g{F.U, F.Win_t, NTOK, DIN, DM}; pg8::StaticOrder S; S.init(NTOK, DIN, F.G, (int)blockIdx.x);
        pg8::EpiProj E{F.PROJ, DIN, att::QSCALE};
        pg8::gemm_phase<pg8::EpiProj, pg8::StaticOrder, PG8_ALIGN, PG8_SP2>(F.lds + RING_OFF, g, S, E);
        if (BOTH(2)) GRID_BAR(2);
    }
    if (IN(3)) {
        const att::Consts cs{args.in[16], args.in[10], args.in[11], args.in[12], args.in[13], args.in[14], args.in[15]};
        const att::bf16* P = (const att::bf16*)F.PROJ; att::bf16* CC = (att::bf16*)F.U;
        att::lds_ptr al = (att::lds_ptr)(F.lds + RING_OFF);
        for (int s = F.vcu; s < 512; s += F.G) {
            const int v = s & 255, bh = v >> 5, qt = (v & 31) + 32 * (s >> 8);
            att::attn_unit<0>(P, CC, cs, (long)NPROMPT + (long)(bh >> 2) * SEQ_S, qt * 128, 0, SEQ_S / 64, bh & 3, al);
        }
        for (int s = F.vcu; s < 1024; s += F.G) {
            const int v = s & 255, bh = (v >> 5) * 4 + (s >> 8), qt = v & 31;
            att::attn_unit<0>(P, CC, cs, (long)(bh >> 2) * SEQ_P, qt * 128, 0, SEQ_P / 64, bh & 3, al);
        }
        for (int s = F.vcu; s < 1536; s += F.G) {
            const int v = s & 255, uid = v * 6 + (s >> 8), blk = uid >> 2, hd = uid & 3;
            long rowbase; int S, qb;
            if (blk < 256) { rowbase = (long)(blk >> 5) * SEQ_P; S = SEQ_P; qb = blk & 31; }
            else { const int bb = blk - 256; rowbase = (long)NPROMPT + (long)(bb >> 6) * SEQ_S; S = SEQ_S; qb = bb & 63; }
            const int q0 = qb * 128, klo = q0 - 128 < 0 ? 0 : q0 - 128, khi = q0 + 256 > S ? S : q0 + 256;
            att::attn_unit<1>(P, CC, cs, rowbase, q0, klo / 64, (khi - klo) / 64, hd, al);
        }
        if (BOTH(3)) GRID_BAR(3);
    }
    if (IN(4)) {
        pg8::Gemm g{F.U, F.Wout_t, NTOK, DM, DM}; pg8::StaticOrder S; S.init(NTOK, DM, F.G, (int)blockIdx.x);
        pg8::EpiResid E{F.xp, F.xs, F.MOD, F.out};
        pg8::gemm_phase<pg8::EpiResid, pg8::StaticOrder, PG8_ALIGN, PG8_SP2>(F.lds + RING_OFF, g, S, E);
        if (BOTH(4)) GRID_BAR(4);
    }
    if (IN(5)) { p5_layernorm(F); }
#undef IN
#undef BOTH
}

extern "C" void kernel_launch(void* const* d_in, const int* in_sizes, int n_in, void* d_out, int out_size, void* d_ws, size_t ws_size, hipStream_t stream) {
    static int grid = 0;
    if (grid == 0) {
        if (n_in != 17 || out_size != NTOK * DM || ws_size < WS_END) { fprintf(stderr, "kernel_launch: unexpected shapes (n_in %d out %d ws %zu); nothing launched\n", n_in, out_size, ws_size); grid = -1; return; }
        int dev = 0, cus = 0, per_cu = 0;
        if (hipGetDevice(&dev) != hipSuccess || hipDeviceGetAttribute(&cus, hipDeviceAttributeMultiprocessorCount, dev) != hipSuccess) { fprintf(stderr, "kernel_launch: device query failed\n"); grid = -1; return; }
        if (hipFuncSetAttribute((const void*)mega_fwd, hipFuncAttributeMaxDynamicSharedMemorySize, LDS_BYTES) != hipSuccess) { fprintf(stderr, "kernel_launch: hipFuncSetAttribute failed\n"); grid = -1; return; }
        if (hipOccupancyMaxActiveBlocksPerMultiprocessor(&per_cu, (const void*)mega_fwd, NWAVES * 64, LDS_BYTES) != hipSuccess || per_cu < 1)
            fprintf(stderr, "kernel_launch: note: occupancy query reports %d workgroups per CU\n", per_cu);
        (void)hipGetLastError();
        grid = cus;
    }
    if (grid < 0) return;
    if (hipMemsetAsync((char*)d_ws + WS_CTL, 0, CTL_ZERO_BYTES, stream) != hipSuccess) { fprintf(stderr, "kernel_launch: hipMemsetAsync failed\n"); return; }
    Args a{};
    for (int i = 0; i < 17; ++i) a.in[i] = (const float*)d_in[i];
    a.out = (float*)d_out; a.ws = (unsigned char*)d_ws;
    for (int li = 0; li < N_LAUNCHES; ++li) {
        a.ph_lo = (N_LAUNCHES == PER_PHASE) ? li : 0; a.ph_hi = (N_LAUNCHES == PER_PHASE) ? li + 1 : PER_PHASE; a.li = li;
        hipLaunchKernelGGL(mega_fwd, dim3(grid), dim3(NWAVES * 64), LDS_BYTES, stream, a);
        const hipError_t le = hipPeekAtLastError();
        if (le != hipSuccess) { fprintf(stderr, "kernel_launch: launch %d failed: %s\n", li, hipGetErrorName(le)); break; }
    }
}
```
